# Optimizing an MI355X kernel written in HIP

```python
import jax, jax.numpy as jnp
from jax import lax
import numpy as np

D_MODEL = 1024
BATCH = 32
SEQ = 2048
DEPTH = 1
DEC_BATCH = 2
DEC_SEQ = 16384
PAST_LEN = 128

GRID_W = 64
HEAD_DIM = 64
RWKV_WIDTH = D_MODEL // 2
RWKV_HEADS = RWKV_WIDTH // HEAD_DIM
ATT_WIDTH = D_MODEL - RWKV_WIDTH
ATT_Q_HEADS = ATT_WIDTH // HEAD_DIM
ATT_KV_HEADS = 2
ATT_GROUP = ATT_Q_HEADS // ATT_KV_HEADS
KV_WIDTH = ATT_KV_HEADS * HEAD_DIM
W_LORA = 64
A_LORA = 64
G_LORA = 128
D_FF = -(-8 * D_MODEL // (3 * 256)) * 256
Q_BLOCK = 128
ROPE_THETA = 10000.0
ROPE_PAIRS = HEAD_DIM // 4
NORM_EPS = 1e-6
LNX_EPS = 64e-5

RWKV_SPLIT = [RWKV_WIDTH, RWKV_WIDTH, RWKV_WIDTH, W_LORA, W_LORA, A_LORA, A_LORA, G_LORA]
RWKV_COLS = int(sum(RWKV_SPLIT))
ATT_SPLIT = [ATT_WIDTH, KV_WIDTH, KV_WIDTH]
IN_COLS = RWKV_COLS + int(sum(ATT_SPLIT))
RWKV_SPLIT_IDX = [int(i) for i in np.cumsum(RWKV_SPLIT)[:-1]]
ATT_SPLIT_IDX = [int(i) for i in np.cumsum(ATT_SPLIT)[:-1]]

kernel_name = 'hybrid_rwkv7_axial_gqa_encoder'


def rms_norm(x, g):
    xf = x.astype(jnp.float32)
    y = xf * lax.rsqrt(jnp.mean(xf * xf, axis=-1, keepdims=True) + NORM_EPS)
    return (y * g.astype(jnp.float32)).astype(x.dtype)


def centred_shift(z, mu_prev, mu_next):
    z_prev = jnp.pad(z[:, :-1], ((0, 0), (1, 0), (0, 0)))
    z_next = jnp.pad(z[:, 1:], ((0, 0), (0, 1), (0, 0)))
    return z + mu_prev * (z_prev - z) + mu_next * (z_next - z)


def wkv7_scan(r, decay, k, v, a_vec, b_vec, reverse):
    B, T, H, N = r.shape
    xs = tuple(jnp.swapaxes(t, 0, 1) for t in (r, decay, k, v, a_vec, b_vec))

    def step(S, inp):
        r_t, w_t, k_t, v_t, a_t, b_t = inp
        sa = jnp.einsum('bhvk,bhk->bhv', S, a_t)
        S = S * w_t[:, :, None, :] + sa[..., None] * b_t[:, :, None, :] + v_t[..., None] * k_t[:, :, None, :]
        return S, jnp.einsum('bhvk,bhk->bhv', S, r_t)

    S0 = jnp.zeros((B, H, N, N), jnp.float32)
    _, ys = lax.scan(step, S0, xs, reverse=reverse)
    return jnp.swapaxes(ys, 0, 1)


def rwkv7_mix(z, mu_prev, mu_next, k_k, k_a, r_k, w0_f, w_lora_f, w0_b, w_lora_b,
              a0_f, a_lora_f, a0_b, a_lora_b, g_lora, lnx_w, lnx_b):
    B, T, _ = z.shape
    f32 = jnp.float32
    zf = centred_shift(z.astype(f32), mu_prev.astype(f32), mu_next.astype(f32))
    r, k, v, wd_f, wd_b, ad_f, ad_b, gd = jnp.split(zf, RWKV_SPLIT_IDX, axis=-1)

    def heads(t):
        return t.reshape(B, T, RWKV_HEADS, HEAD_DIM)

    kk = heads(k * k_k.astype(f32))
    kk = kk * lax.rsqrt(jnp.maximum(jnp.sum(kk * kk, axis=-1, keepdims=True), 1e-12))
    r_h, v_h = heads(r), heads(v)

    def direction(wd, w0, w_lora, ad, a0, a_lora, reverse):
        w_log = -jax.nn.softplus(-(w0.astype(f32) + jnp.tanh(wd) @ w_lora.astype(f32))) - 0.5
        decay = heads(jnp.exp(-jnp.exp(w_log)))
        a = jax.nn.sigmoid(a0.astype(f32) + ad @ a_lora.astype(f32))
        kd = heads(k * (1.0 + (a - 1.0) * k_a.astype(f32)))
        y = wkv7_scan(r_h, decay, kd, v_h, -kk, kk * heads(a), reverse)
        return y, kd

    y_f, kd_f = direction(wd_f, w0_f, w_lora_f, ad_f, a0_f, a_lora_f, False)
    y_b, kd_b = direction(wd_b, w0_b, w_lora_b, ad_b, a0_b, a_lora_b, True)
    y = y_f + y_b
    mu = jnp.mean(y, axis=-1, keepdims=True)
    var = jnp.mean(jnp.square(y - mu), axis=-1, keepdims=True)
    yn = ((y - mu) * lax.rsqrt(var + LNX_EPS)).reshape(B, T, RWKV_WIDTH)
    yn = yn * lnx_w.astype(f32) + lnx_b.astype(f32)
    kb = 0.5 * (kd_f + kd_b)
    bonus = (jnp.sum(r_h * kb * r_k.astype(f32), axis=-1, keepdims=True) * v_h).reshape(B, T, RWKV_WIDTH)
    g = jax.nn.sigmoid(gd) @ g_lora.astype(f32)
    return ((yn + bonus) * g).astype(z.dtype)


def axial_angles(T):
    n_rows = T // GRID_W
    row = jnp.broadcast_to(jnp.arange(n_rows, dtype=jnp.float32)[:, None], (n_rows, GRID_W)).reshape(-1)
    col = jnp.broadcast_to(jnp.arange(GRID_W, dtype=jnp.float32)[None, :], (n_rows, GRID_W)).reshape(-1)
    inv = ROPE_THETA ** (-jnp.arange(ROPE_PAIRS, dtype=jnp.float32) / ROPE_PAIRS)
    return row[:, None] * inv, col[:, None] * inv


def rope_half(x, ang):
    c = jnp.cos(ang)[None, :, None, :].astype(x.dtype)
    s = jnp.sin(ang)[None, :, None, :].astype(x.dtype)
    x1, x2 = x[..., :ROPE_PAIRS], x[..., ROPE_PAIRS:]
    return jnp.concatenate([x1 * c - x2 * s, x1 * s + x2 * c], axis=-1)


def axial_rope(x, ang_row, ang_col):
    h = HEAD_DIM // 2
    return jnp.concatenate([rope_half(x[..., :h], ang_row), rope_half(x[..., h:], ang_col)], axis=-1)


def axial_gqa(z, q_gain, k_gain):
    B, T, _ = z.shape
    q, k, v = jnp.split(z, ATT_SPLIT_IDX, axis=-1)
    q = q.reshape(B, T, ATT_Q_HEADS, HEAD_DIM)
    k = k.reshape(B, T, ATT_KV_HEADS, HEAD_DIM)
    v = v.reshape(B, T, ATT_KV_HEADS, HEAD_DIM)
    ang_row, ang_col = axial_angles(T)
    q = axial_rope(rms_norm(q, q_gain), ang_row, ang_col)
    k = axial_rope(rms_norm(k, k_gain), ang_row, ang_col)
    nb = T // Q_BLOCK
    qb = q.reshape(B, nb, Q_BLOCK, ATT_KV_HEADS, ATT_GROUP, HEAD_DIM).transpose(1, 0, 2, 3, 4, 5)
    scale = HEAD_DIM ** -0.5

    def block(q_blk):
        s = jnp.einsum('bqhgd,bkhd->bhgqk', q_blk, k).astype(jnp.float32) * scale
        p = jax.nn.softmax(s, axis=-1).astype(v.dtype)
        return jnp.einsum('bhgqk,bkhd->bqhgd', p, v)

    o = lax.map(block, qb)
    return o.transpose(1, 0, 2, 3, 4, 5).reshape(B, T, ATT_WIDTH)


def encoder_layer(x, norm1_g, w_in, mu_prev, mu_next, k_k, k_a, r_k, w0_f, w_lora_f, w0_b, w_lora_b,
                  a0_f, a_lora_f, a0_b, a_lora_b, g_lora, lnx_w, lnx_b, q_gain, k_gain, w_out,
                  norm2_g, ffn_gate, ffn_up, ffn_down):
    h = rms_norm(x, norm1_g)
    z = h @ w_in
    y_rwkv = rwkv7_mix(z[..., :RWKV_COLS], mu_prev, mu_next, k_k, k_a, r_k, w0_f, w_lora_f, w0_b,
                       w_lora_b, a0_f, a_lora_f, a0_b, a_lora_b, g_lora, lnx_w, lnx_b)
    y_att = axial_gqa(z[..., RWKV_COLS:], q_gain, k_gain)
    x = x + jnp.concatenate([y_rwkv, y_att], axis=-1) @ w_out
    h = rms_norm(x, norm2_g)
    x = x + (jax.nn.silu(h @ ffn_gate) * (h @ ffn_up)) @ ffn_down
    return x


def trunk(x, layer_params, norm_f_g):
    for l in range(DEPTH):
        x = encoder_layer(x, *[p[l] for p in layer_params])
    return rms_norm(x, norm_f_g)


def setup_inputs(seed: int = 0) -> dict:
    key = jax.random.key(seed)
    ks = jax.random.split(key, 32)
    L, D, RW, H, N = DEPTH, D_MODEL, RWKV_WIDTH, RWKV_HEADS, HEAD_DIM
    nrm = jax.random.normal
    f32 = jnp.float32
    return {
        'x_prompt': nrm(ks[0], (BATCH, SEQ, D), f32),
        'x_sample': nrm(ks[1], (DEC_BATCH, DEC_SEQ, D), f32),
        'norm1_g': 1.0 + 0.02 * nrm(ks[2], (L, D), f32),
        'w_in': nrm(ks[3], (L, D, IN_COLS), f32) * D ** -0.5,
        'mu_prev': jax.random.uniform(ks[4], (L, RWKV_COLS), f32, 0.0, 0.4),
        'mu_next': jax.random.uniform(ks[5], (L, RWKV_COLS), f32, 0.0, 0.4),
        'k_k': 0.85 + 0.05 * nrm(ks[6], (L, RW), f32),
        'k_a': 1.0 + 0.05 * nrm(ks[7], (L, RW), f32),
        'r_k': 0.1 * nrm(ks[8], (L, H, N), f32),
        'w0_f': jax.random.uniform(ks[9], (L, RW), f32, -6.0, 1.0),
        'w_lora_f': 0.1 * nrm(ks[10], (L, W_LORA, RW), f32) * W_LORA ** -0.5,
        'w0_b': jax.random.uniform(ks[11], (L, RW), f32, -6.0, 1.0),
        'w_lora_b': 0.1 * nrm(ks[12], (L, W_LORA, RW), f32) * W_LORA ** -0.5,
        'a0_f': 0.1 * nrm(ks[13], (L, RW), f32),
        'a_lora_f': 0.1 * nrm(ks[14], (L, A_LORA, RW), f32) * A_LORA ** -0.5,
        'a0_b': 0.1 * nrm(ks[15], (L, RW), f32),
        'a_lora_b': 0.1 * nrm(ks[16], (L, A_LORA, RW), f32) * A_LORA ** -0.5,
        'g_lora': nrm(ks[17], (L, G_LORA, RW), f32) * G_LORA ** -0.5,
        'lnx_w': 1.0 + 0.02 * nrm(ks[18], (L, RW), f32),
        'lnx_b': 0.01 * nrm(ks[19], (L, RW), f32),
        'q_gain': 1.0 + 0.02 * nrm(ks[20], (L, HEAD_DIM), f32),
        'k_gain': 1.0 + 0.02 * nrm(ks[21], (L, HEAD_DIM), f32),
        'w_out': nrm(ks[22], (L, D, D), f32) * D ** -0.5,
        'norm2_g': 1.0 + 0.02 * nrm(ks[23], (L, D), f32),
        'ffn_gate': nrm(ks[24], (L, D, D_FF), f32) * D ** -0.5,
        'ffn_up': nrm(ks[25], (L, D, D_FF), f32) * D ** -0.5,
        'ffn_down': nrm(ks[26], (L, D_FF, D), f32) * D_FF ** -0.5,
        'norm_f_g': 1.0 + 0.02 * nrm(ks[27], (D,), f32),
    }


def reference(x_prompt, x_sample, norm1_g, w_in, mu_prev, mu_next, k_k, k_a, r_k, w0_f, w_lora_f,
              w0_b, w_lora_b, a0_f, a_lora_f, a0_b, a_lora_b, g_lora, lnx_w, lnx_b, q_gain, k_gain,
              w_out, norm2_g, ffn_gate, ffn_up, ffn_down, norm_f_g):
    layer_params = (norm1_g, w_in, mu_prev, mu_next, k_k, k_a, r_k, w0_f, w_lora_f, w0_b, w_lora_b,
                    a0_f, a_lora_f, a0_b, a_lora_b, g_lora, lnx_w, lnx_b, q_gain, k_gain, w_out,
                    norm2_g, ffn_gate, ffn_up, ffn_down)
    y_prompt = trunk(x_prompt, layer_params, norm_f_g)
    y_sample = trunk(x_sample, layer_params, norm_f_g)
    return (y_prompt, y_sample)
```

```cpp
#include <hip/hip_runtime.h>
#include <hip/hip_cooperative_groups.h>
#include <cstdio>
#include <cstdint>
#ifndef MK_N_LAUNCHES
#define MK_N_LAUNCHES 1
#endif
namespace pg8 {
#define PG8_LAS __attribute__((address_space(3)))
typedef unsigned short bf16_t;
typedef short bf16x8 __attribute__((ext_vector_type(8)));
typedef float f32x4 __attribute__((ext_vector_type(4)));
typedef unsigned u32x4 __attribute__((ext_vector_type(4)));
constexpr int BM = 256, BK = 64, HALF = 128, HTB = HALF * BK * 2  , STAGE_BYTES = 8 * HTB, NXCD = 8, WGM = 8;

__host__ __device__ __forceinline__ int lds_byte(int r, int c) { const int st = (r >> 4) * 2 + (c >> 5), rr = r & 15, cc = c & 31, ob = rr * 64 + cc * 2; return st * 1024 + (ob ^ (((ob >> 9) & 1) << 5)); }
__host__ __device__ __forceinline__ void stage_rc(int b, int& R, int& C) { const int st = b / 1024, sb = b % 1024, swz = sb ^ (((sb >> 9) & 1) << 5); R = (st >> 1) * 16 + swz / 64; C = (st & 1) * 32 + (swz % 64) / 2; }
__host__ __device__ __forceinline__ int perm32(int rho) { const int n = rho >> 4, i = rho & 15; return 8 * (i >> 2) + 4 * n + (i & 3); }

struct Unit { int pm, pn; };
struct Gemm { const bf16_t* A; const bf16_t* Bt; int M, N, K; };

struct StaticOrder {
    int nM, nN, nwg, G, c;
    __host__ __device__ void init(int M, int N, int G_, int c_) { nM = M / BM; nN = N / BM; nwg = nM * nN; G = G_; c = c_; }
    __host__ __device__ bool next(int i, Unit& u) const {
        const long L = (long)i * G + c; if (L >= nwg) return false;
        int wgid = (int)L; { const int q = nwg / NXCD, r = nwg % NXCD, xcd = wgid % NXCD, off = wgid / NXCD; wgid = (xcd < r ? xcd * (q + 1) : r * (q + 1) + (xcd - r) * q) + off; }
        const int nig = WGM * nN, gid = wgid / nig, fm = gid * WGM, gsz = (nM - fm) < WGM ? (nM - fm) : WGM;
        u.pm = fm + ((wgid % nig) % gsz); u.pn = (wgid % nig) / gsz; return true;
    }
    __device__ __forceinline__ void a_ready(const Unit&) const {}
    __device__ __forceinline__ void done(const Unit&) const {}
};

__device__ __forceinline__ unsigned cvt_pk_bf16(float lo, float hi) { unsigned r; asm volatile("v_cvt_pk_bf16_f32 %0, %1, %2" : "=v"(r) : "v"(lo), "v"(hi)); return r; }
typedef float f32x2 __attribute__((ext_vector_type(2)));
__device__ __forceinline__ f32x2 gelu_pk(f32x2 v) {
    const f32x2 av = __builtin_elementwise_abs(v), d = av * 0.2316418882f + 1.0f;
    f32x2 t; t.x = __builtin_amdgcn_rcpf(d.x); t.y = __builtin_amdgcn_rcpf(d.y);
    f32x2 q = t * 0.5307027145f + (-0.7265760135f); q = q * t + 0.7107068705f; q = q * t + (-0.142248368f); q = q * t + 0.127414796f; q = q * t;
    const f32x2 s = (v * v) * (-0.72134752044f);
    f32x2 e; e.x = __builtin_amdgcn_exp2f(s.x); e.y = __builtin_amdgcn_exp2f(s.y);
    const f32x2 m = v * (q * e), r = v - m;
    f32x2 o; o.x = v.x < 0.f ? m.x : r.x; o.y = v.y < 0.f ? m.y : r.y; return o;
}

template <int ACT  > struct EpiBf16 {
    static constexpr bool PERM = true, AFTER_DRAIN = false; static_assert(ACT == 0 || ACT == 1, "EpiBf16: ACT is 0 (none) or 1 (gelu_pk)");
    bf16_t* O; int ldc; const float* bias; int split_cols; size_t split_stride; float scale0;
    __device__ __forceinline__ void operator()(const f32x4 (&acc)[2][2][4][2], const Unit& u, int wr, int wc, int fr, int fq) const {
        const int row0 = u.pm * BM + wr * 64 + fr; int colt = u.pn * BM; bf16_t* base = O;
        float sc = 1.f; if (split_cols) { const int t = colt / split_cols; base += (size_t)t * split_stride; colt -= t * split_cols; if (t == 0) sc = scale0; }
        const int col0 = colt + wc * 32 + 8 * fq, bcol0 = u.pn * BM + wc * 32 + 8 * fq;
        f32x4 bv[2][2];
#pragma unroll
        for (int bj = 0; bj < 2; ++bj)
#pragma unroll
            for (int n = 0; n < 2; ++n) bv[bj][n] = bias ? *(const f32x4*)(bias + bcol0 + bj * HALF + 4 * n) : (f32x4){0.f, 0.f, 0.f, 0.f};
#pragma unroll
        for (int ai = 0; ai < 2; ++ai)
#pragma unroll
            for (int m = 0; m < 4; ++m) { bf16_t* rowp = base + (size_t)(row0 + ai * HALF + m * 16) * ldc + col0;
#pragma unroll
                for (int bj = 0; bj < 2; ++bj) { f32x4 v0 = acc[ai][bj][m][0] + bv[bj][0], v1 = acc[ai][bj][m][1] + bv[bj][1];
                    if (ACT == 1) { f32x2 a = gelu_pk((f32x2){v0[0], v0[1]}), b = gelu_pk((f32x2){v0[2], v0[3]}), c = gelu_pk((f32x2){v1[0], v1[1]}), d = gelu_pk((f32x2){v1[2], v1[3]});
                        v0 = (f32x4){a.x, a.y, b.x, b.y}; v1 = (f32x4){c.x, c.y, d.x, d.y}; }
                    v0 = v0 * sc; v1 = v1 * sc; u32x4 w; w.x = cvt_pk_bf16(v0[0], v0[1]); w.y = cvt_pk_bf16(v0[2], v0[3]); w.z = cvt_pk_bf16(v1[0], v1[1]); w.w = cvt_pk_bf16(v1[2], v1[3]);
                    *(u32x4*)(rowp + bj * HALF) = w; } }
    }
};
typedef _Float16 f16x8 __attribute__((ext_vector_type(8)));
__device__ __forceinline__ unsigned cvt_pk_f16(float lo, float hi) { unsigned r; asm volatile("v_cvt_pk_f16_f32 %0, %1, %2" : "=v"(r) : "v"(lo), "v"(hi)); return r; }
struct EpiLora {
    static constexpr bool PERM = true, AFTER_DRAIN = false;
    _Float16* T16; size_t tstride; _Float16* G;
    __device__ __forceinline__ void operator()(const f32x4 (&acc)[2][2][4][2], const Unit& u, int wr, int wc, int fr, int fq) const {
        const int tt = u.pn >> 1, colt = (u.pn & 1) * 256;
        const int row0 = u.pm * BM + wr * 64 + fr, col0 = colt + wc * 32 + 8 * fq;
        _Float16* base = (tt < 4) ? T16 + (size_t)tt * tstride : G;
#pragma unroll
        for (int ai = 0; ai < 2; ++ai)
#pragma unroll
            for (int m = 0; m < 4; ++m) { _Float16* rowp = base + (size_t)(row0 + ai * HALF + m * 16) * 512 + col0;
#pragma unroll
                for (int bj = 0; bj < 2; ++bj) {
                    const f32x4 v0 = acc[ai][bj][m][0], v1 = acc[ai][bj][m][1];
                    u32x4 w; w.x = cvt_pk_f16(v0[0], v0[1]); w.y = cvt_pk_f16(v0[2], v0[3]); w.z = cvt_pk_f16(v1[0], v1[1]); w.w = cvt_pk_f16(v1[2], v1[3]);
                    *(u32x4*)(rowp + bj * HALF) = w;
                }
            }
    }
};
template <bool BF_SSQ> struct EpiRes {
    static constexpr bool PERM = true, AFTER_DRAIN = false;
    const float* baseP; const float* baseS; float* out; bf16_t* xb; float* ssq;
    __device__ __forceinline__ void operator()(const f32x4 (&acc)[2][2][4][2], const Unit& u, int wr, int wc, int fr, int fq) const {
        const int row0 = u.pm * BM + wr * 64 + fr, col0 = u.pn * BM + wc * 32 + 8 * fq;
        const float* base = (u.pm < 256) ? baseP : baseS - (size_t)65536 * 1024;
#pragma unroll
        for (int ai = 0; ai < 2; ++ai)
#pragma unroll
            for (int m = 0; m < 4; ++m) {
                const int row = row0 + ai * HALF + m * 16; const size_t off = (size_t)row * 1024 + col0; float s = 0.f;
#pragma unroll
                for (int bj = 0; bj < 2; ++bj) {
                    const f32x4 x0 = *(const f32x4*)(base + off + bj * HALF), x1 = *(const f32x4*)(base + off + bj * HALF + 4);
                    const f32x4 v0 = acc[ai][bj][m][0] + x0, v1 = acc[ai][bj][m][1] + x1;
                    *(f32x4*)(out + off + bj * HALF) = v0; *(f32x4*)(out + off + bj * HALF + 4) = v1;
                    if (BF_SSQ) {
                        s += (v0[0] * v0[0] + v0[1] * v0[1]) + (v0[2] * v0[2] + v0[3] * v0[3]) + (v1[0] * v1[0] + v1[1] * v1[1]) + (v1[2] * v1[2] + v1[3] * v1[3]);
                        u32x4 w; w.x = cvt_pk_bf16(v0[0], v0[1]); w.y = cvt_pk_bf16(v0[2], v0[3]); w.z = cvt_pk_bf16(v1[0], v1[1]); w.w = cvt_pk_bf16(v1[2], v1[3]);
                        *(u32x4*)(xb + off + bj * HALF) = w;
                    }
                }
                if (BF_SSQ) { s += __shfl_xor(s, 16); s += __shfl_xor(s, 32); if (fq == 0) atomicAdd(ssq + row, s); }
            }
    }
};
struct EpiSwiGLU {
    static constexpr bool PERM = true, AFTER_DRAIN = false;
    bf16_t* act; const float* ssq;
    __device__ __forceinline__ void operator()(const f32x4 (&acc)[2][2][4][2], const Unit& u, int wr, int wc, int fr, int fq) const {
        const int row0 = u.pm * BM + wr * 64 + fr, col0 = u.pn * HALF + wc * 32 + 8 * fq;
#pragma unroll
        for (int ai = 0; ai < 2; ++ai)
#pragma unroll
            for (int m = 0; m < 4; ++m) {
                const int row = row0 + ai * HALF + m * 16;
                const float rstd = 1.0f / sqrtf(ssq[row] * (1.0f / 1024.0f) + 1e-6f);
                float o[8];
#pragma unroll
                for (int n = 0; n < 2; ++n)
#pragma unroll
                    for (int i = 0; i < 4; ++i) { const float g = acc[ai][0][m][n][i] * rstd, up = acc[ai][1][m][n][i] * rstd; o[n * 4 + i] = g * up * __builtin_amdgcn_rcpf(1.0f + __expf(-g)); }
                u32x4 w; w.x = cvt_pk_bf16(o[0], o[1]); w.y = cvt_pk_bf16(o[2], o[3]); w.z = cvt_pk_bf16(o[4], o[5]); w.w = cvt_pk_bf16(o[6], o[7]);
                *(u32x4*)(act + (size_t)row * 2816 + col0) = w;
            }
    }
};


template <class Epi, class Sched, bool ALIGN_EPI = false, bool SP2 = false>
__device__ __forceinline__ void gemm_phase(PG8_LAS unsigned char* lds, const Gemm g, const Sched& S, const Epi& E) {
    const int tid = threadIdx.x, wid = __builtin_amdgcn_readfirstlane(tid >> 6), lane = tid & 63, wr = wid >> 2, wc = wid & 3, fr = lane & 15, fq = lane >> 4;
    const int K = g.K, nt = K / BK;
    unsigned voffA[2], voffB[2];
#pragma unroll
    for (int i = 0; i < 2; ++i) { int R, C; stage_rc(tid * 16 + i * 8192, R, C); const int Rb = Epi::PERM ? ((R & ~31) + perm32(R & 31)) : R;
        voffA[i] = (unsigned)(R * K + C) * 2u; voffB[i] = (unsigned)(Rb * K + C) * 2u; }
    const size_t kstep = (size_t)(BK * 2);
    const size_t hstep = (size_t)HALF * K * 2;
    const size_t tstep = 2 * hstep;
    const unsigned ldsw = (unsigned)wid * 1024u;
    const int aoff = lds_byte(wr * 64 + fr, fq * 8), boff = lds_byte(wc * 32 + fr, fq * 8);
#define PG8_SA(b, h) (((b) * 2 + (h)) * HTB)
#define PG8_SB(b, h) ((4 + (b) * 2 + (h)) * HTB)
#define PG8_STAGE(bufoff, gbase, voff) do { _Pragma("unroll") for (int _i = 0; _i < 2; ++_i) \
        __builtin_amdgcn_global_load_lds((const unsigned*)((const char*)(gbase) + (voff)[_i]), (PG8_LAS unsigned*)(lds + (bufoff) + ldsw + _i * 8192), 16, 0, 0); } while (0)
#define PG8_LDA(dst, b, h) do { _Pragma("unroll") for (int m = 0; m < 4; ++m) _Pragma("unroll") for (int k = 0; k < 2; ++k) dst[m][k] = *(const PG8_LAS bf16x8*)(lds + PG8_SA(b, h) + aoff + m * 2048 + k * 1024); } while (0)
#define PG8_LDB(dst, b, h) do { _Pragma("unroll") for (int n = 0; n < 2; ++n) _Pragma("unroll") for (int k = 0; k < 2; ++k) dst[n][k] = *(const PG8_LAS bf16x8*)(lds + PG8_SB(b, h) + boff + n * 2048 + k * 1024); } while (0)
#define PG8_MMA(ai, bj, At, Bt) do { __builtin_amdgcn_s_setprio(1); _Pragma("unroll") for (int m = 0; m < 4; ++m) _Pragma("unroll") for (int n = 0; n < 2; ++n) _Pragma("unroll") for (int k = 0; k < 2; ++k) \
        acc[ai][bj][m][n] = __builtin_amdgcn_mfma_f32_16x16x32_bf16(Bt[n][k], At[m][k], acc[ai][bj][m][n], 0, 0, 0); __builtin_amdgcn_s_setprio(0); } while (0)
#define PG8_WAIT_V(n) asm volatile("s_waitcnt vmcnt(" #n ")" ::: "memory")
#define PG8_WAIT_L(n) asm volatile("s_waitcnt lgkmcnt(" #n ")" ::: "memory")
#define PG8_BAR __builtin_amdgcn_s_barrier()
#define PG8_SCHED __builtin_amdgcn_sched_barrier(0)
    Unit cur, nxt; int ui = 0;
    if (!S.next(0, cur)) return;
    f32x4 acc[2][2][4][2];
#pragma unroll
    for (int a = 0; a < 2; ++a)
#pragma unroll
        for (int b = 0; b < 2; ++b)
#pragma unroll
            for (int m = 0; m < 4; ++m)
#pragma unroll
                for (int n = 0; n < 2; ++n) acc[a][b][m][n] = (f32x4){0.f, 0.f, 0.f, 0.f};
    bf16x8 At[4][2], B0[2][2], B1[2][2];
    const char* cA = (const char*)g.A + (size_t)cur.pm * tstep; const char* cB = (const char*)g.Bt + (size_t)cur.pn * tstep;
    S.a_ready(cur);
    if constexpr (SP2) {
        PG8_STAGE(PG8_SB(0, 0), cB, voffB); PG8_STAGE(PG8_SB(0, 1), cB + hstep, voffB); PG8_STAGE(PG8_SA(0, 0), cA, voffA); PG8_STAGE(PG8_SA(0, 1), cA + hstep, voffA);
        if (wr == 1) PG8_BAR;
        PG8_WAIT_V(2); PG8_BAR;
        PG8_STAGE(PG8_SB(1, 0), cB + kstep, voffB); PG8_STAGE(PG8_SA(1, 0), cA + kstep, voffA); PG8_STAGE(PG8_SB(1, 1), cB + hstep + kstep, voffB);
        PG8_WAIT_V(6); PG8_BAR;
    } else {
        PG8_STAGE(PG8_SB(0, 0), cB, voffB); PG8_STAGE(PG8_SA(0, 0), cA, voffA); PG8_STAGE(PG8_SB(0, 1), cB + hstep, voffB); PG8_STAGE(PG8_SA(0, 1), cA + hstep, voffA);
        if (wr == 1) PG8_BAR;
        PG8_WAIT_V(4); PG8_BAR;
        PG8_STAGE(PG8_SB(1, 0), cB + kstep, voffB); PG8_STAGE(PG8_SA(1, 0), cA + kstep, voffA); PG8_STAGE(PG8_SB(1, 1), cB + hstep + kstep, voffB);
        PG8_WAIT_V(6); PG8_BAR;
    }
    for (;;) {
        const bool has_next = S.next(ui + 1, nxt);
        const char* nA = has_next ? (const char*)g.A + (size_t)nxt.pm * tstep : cA; const char* nB = has_next ? (const char*)g.Bt + (size_t)nxt.pn * tstep : cB;
#pragma nounroll
        for (int t = 0; t < nt; t += 2) {
            const bool last = (t == nt - 2);
            const char* a1 = cA + (size_t)(t + 1) * kstep;
            const char* a2 = last ? nA : cA + (size_t)(t + 2) * kstep; const char* b2 = last ? nB : cB + (size_t)(t + 2) * kstep;
            const char* a3 = a2 + kstep; const char* b3 = b2 + kstep;
            if (last && has_next) S.a_ready(nxt);
            if constexpr (SP2) {
            PG8_LDB(B0, 0, 0); PG8_LDB(B1, 0, 1); PG8_SCHED; PG8_LDA(At, 0, 0); PG8_STAGE(PG8_SA(1, 1), a1 + hstep, voffA);
            PG8_WAIT_V(8); PG8_WAIT_L(0); PG8_BAR; PG8_MMA(0, 0, At, B0); PG8_MMA(0, 1, At, B1); PG8_BAR; PG8_SCHED;
            PG8_LDA(At, 0, 1); PG8_STAGE(PG8_SB(0, 0), b2, voffB); PG8_STAGE(PG8_SB(0, 1), b2 + hstep, voffB); PG8_STAGE(PG8_SA(0, 0), a2, voffA);
            PG8_WAIT_V(8); PG8_WAIT_L(0); PG8_BAR; PG8_MMA(1, 0, At, B0); PG8_MMA(1, 1, At, B1); PG8_BAR; PG8_SCHED;
            PG8_LDB(B0, 1, 0); PG8_LDB(B1, 1, 1); PG8_SCHED; PG8_LDA(At, 1, 0); PG8_STAGE(PG8_SA(0, 1), a2 + hstep, voffA);
            PG8_WAIT_V(8); PG8_WAIT_L(0); PG8_BAR; PG8_MMA(0, 0, At, B0); PG8_MMA(0, 1, At, B1); PG8_BAR; PG8_SCHED;
            PG8_LDA(At, 1, 1); PG8_STAGE(PG8_SB(1, 0), b3, voffB); PG8_STAGE(PG8_SB(1, 1), b3 + hstep, voffB); PG8_STAGE(PG8_SA(1, 0), a3, voffA);
            PG8_WAIT_V(8); PG8_WAIT_L(0); PG8_BAR; PG8_MMA(1, 0, At, B0); PG8_MMA(1, 1, At, B1); PG8_BAR; PG8_SCHED;
            } else {
            PG8_LDB(B0, 0, 0); PG8_SCHED; PG8_LDA(At, 0, 0); PG8_STAGE(PG8_SA(1, 1), a1 + hstep, voffA);
            PG8_WAIT_L(8); PG8_BAR; PG8_WAIT_L(0); PG8_MMA(0, 0, At, B0); PG8_BAR; PG8_SCHED;
            PG8_LDB(B1, 0, 1); PG8_STAGE(PG8_SB(0, 0), b2, voffB);
            PG8_BAR; PG8_WAIT_L(0); PG8_MMA(0, 1, At, B1); PG8_BAR;
            PG8_LDA(At, 0, 1); PG8_STAGE(PG8_SA(0, 0), a2, voffA);
            PG8_BAR; PG8_WAIT_L(0); PG8_MMA(1, 0, At, B0); PG8_BAR; PG8_SCHED;
            PG8_STAGE(PG8_SB(0, 1), b2 + hstep, voffB);
            PG8_WAIT_V(6); PG8_BAR; PG8_MMA(1, 1, At, B1); PG8_BAR;
            PG8_LDB(B0, 1, 0); PG8_SCHED; PG8_LDA(At, 1, 0); PG8_STAGE(PG8_SA(0, 1), a2 + hstep, voffA);
            PG8_WAIT_L(8); PG8_BAR; PG8_WAIT_L(0); PG8_MMA(0, 0, At, B0); PG8_BAR; PG8_SCHED;
            PG8_LDB(B1, 1, 1); PG8_STAGE(PG8_SB(1, 0), b3, voffB);
            PG8_BAR; PG8_WAIT_L(0); PG8_MMA(0, 1, At, B1); PG8_BAR;
            PG8_LDA(At, 1, 1); PG8_STAGE(PG8_SA(1, 0), a3, voffA);
            PG8_BAR; PG8_WAIT_L(0); PG8_MMA(1, 0, At, B0); PG8_BAR; PG8_SCHED;
            PG8_STAGE(PG8_SB(1, 1), b3 + hstep, voffB);
            PG8_WAIT_V(6); PG8_BAR; PG8_MMA(1, 1, At, B1); PG8_BAR;
            }
        }
        if constexpr (ALIGN_EPI) { if (wr == 0) PG8_BAR; }
        if constexpr (!Epi::AFTER_DRAIN) { E(acc, cur, wr, wc, fr, fq); S.done(cur); }
        if (!has_next) break;
#pragma unroll
        for (int a = 0; a < 2; ++a)
#pragma unroll
            for (int b = 0; b < 2; ++b)
#pragma unroll
                for (int m = 0; m < 4; ++m)
#pragma unroll
                    for (int n = 0; n < 2; ++n) acc[a][b][m][n] = (f32x4){0.f, 0.f, 0.f, 0.f};
        cur = nxt; cA = nA; cB = nB; ++ui;
        if constexpr (ALIGN_EPI) { if (wr == 1) PG8_BAR; }
    }
    PG8_WAIT_V(0);
    if constexpr (!ALIGN_EPI) { if (wr == 0) PG8_BAR; }
    PG8_BAR;
    if constexpr (Epi::AFTER_DRAIN) { E.fused(acc, cur, wr, wc, fr, fq, lds, wid, lane); S.done(cur); }
#undef PG8_SA
#undef PG8_SB
#undef PG8_STAGE
#undef PG8_LDA
#undef PG8_LDB
#undef PG8_MMA
#undef PG8_WAIT_V
#undef PG8_WAIT_L
#undef PG8_BAR
#undef PG8_SCHED
}
}
#include <hip/hip_bf16.h>
#include <cmath>
namespace attn_body {
using bf16=__hip_bfloat16;
using bf16x8=__attribute__((ext_vector_type(8)))short;
using s16x4=__attribute__((ext_vector_type(4)))short;
using f32x16=__attribute__((ext_vector_type(16)))float;
using u32x4=__attribute__((ext_vector_type(4)))unsigned;
constexpr int D=64,PZ=2816,PO=1024,ZQ=1920,ZKA=2432,ZVA=2560;
constexpr int NW=8,QBLK=32,QB=QBLK*NW,KVBLK=64;
constexpr int ATTN_UNIT_ROWS=QB;
__device__ __forceinline__ int crow(int r,int hi){return (r&3)+8*(r>>2)+4*hi;}
#define SBAR() __builtin_amdgcn_sched_barrier(0)
__device__ __forceinline__ void cmask(f32x16&p0,f32x16&p1,int jb,int qrel,int hi){
  const float NEG=-INFINITY; int kb=64*jb+4*hi;
  #pragma unroll
  for(int r=0;r<16;++r){int kv=kb+(r&3)+8*(r>>2); if(kv>qrel)p0[r]=NEG; if(kv+32>qrel)p1[r]=NEG;}
}

constexpr int NSLOT=3, SLOTB=8192;
constexpr int LDS_K=0, LDS_V=NSLOT*SLOTB, LDS_WS=2*NSLOT*SLOTB, LDS_OST=LDS_WS+NW*64*4, LDS_BYTES=LDS_OST+NW*4096;
constexpr float C2=0.125f*1.4426950408889634f;
__device__ __forceinline__ void glds16(const void*gsrc,unsigned lds_dst){unsigned keep;
  asm volatile("s_mov_b32 %0, m0\n\ts_mov_b32 m0, %2\n\ts_nop 0\n\tglobal_load_lds_dwordx4 %1, off\n\ts_mov_b32 m0, %0":"=&s"(keep):"v"(gsrc),"s"(lds_dst):"memory");}
__device__ __forceinline__ float max3f(float a,float b,float c){float r;asm("v_max3_f32 %0, %1, %2, %3":"=v"(r):"v"(a),"v"(b),"v"(c));return r;}
__device__ __forceinline__ float max2f(float a,float b){float r;asm("v_max_f32_e32 %0, %1, %2":"=v"(r):"v"(a),"v"(b));return r;}
__device__ __forceinline__ float fadd_s(float a,float b){float r;asm("v_add_f32_e32 %0, %1, %2":"=v"(r):"v"(a),"v"(b));return r;}
__device__ __forceinline__ float fsub_s(float a,float b){float r;asm("v_sub_f32_e32 %0, %1, %2":"=v"(r):"v"(a),"v"(b));return r;}
typedef float f32x2_t __attribute__((ext_vector_type(2))); typedef __bf16 bf16x2_t __attribute__((ext_vector_type(2)));
__device__ __forceinline__ unsigned cvtpk_s(float lo,float hi){f32x2_t v={lo,hi};bf16x2_t b=__builtin_convertvector(v,bf16x2_t);return __builtin_bit_cast(unsigned,b);}
#define WAIT_BAR(N) asm volatile("s_waitcnt vmcnt(" #N ") lgkmcnt(0)\n\ts_barrier":::"memory")

__device__ __forceinline__ void qkt(f32x16&p0,f32x16&p1,const char*Kslot,const bf16x8*qr,const f32x16&negm,int r32,int hi){
  const char*kb=Kslot+hi*1024+r32*16;
  #pragma unroll
  for(int d0=0;d0<4;++d0){
    const bf16x8 b0=*reinterpret_cast<const bf16x8*>(kb+d0*2048);
    const bf16x8 b1=*reinterpret_cast<const bf16x8*>(kb+d0*2048+512);
    if(d0==0){p0=__builtin_amdgcn_mfma_f32_32x32x16_bf16(b0,qr[0],negm,0,0,0);p1=__builtin_amdgcn_mfma_f32_32x32x16_bf16(b1,qr[0],negm,0,0,0);}
    else{p0=__builtin_amdgcn_mfma_f32_32x32x16_bf16(b0,qr[d0],p0,0,0,0);p1=__builtin_amdgcn_mfma_f32_32x32x16_bf16(b1,qr[d0],p1,0,0,0);}}
}
typedef __attribute__((address_space(3))) const char* lds_cptr;
typedef short v4i16_t __attribute__((ext_vector_type(4)));
__device__ __forceinline__ void kload8(bf16x8*kf,lds_cptr kp){
  kf[0]=*(const __attribute__((address_space(3))) bf16x8*)(kp);      kf[1]=*(const __attribute__((address_space(3))) bf16x8*)(kp+512);
  kf[2]=*(const __attribute__((address_space(3))) bf16x8*)(kp+2048); kf[3]=*(const __attribute__((address_space(3))) bf16x8*)(kp+2560);
  kf[4]=*(const __attribute__((address_space(3))) bf16x8*)(kp+4096); kf[5]=*(const __attribute__((address_space(3))) bf16x8*)(kp+4608);
  kf[6]=*(const __attribute__((address_space(3))) bf16x8*)(kp+6144); kf[7]=*(const __attribute__((address_space(3))) bf16x8*)(kp+6656);
}
__device__ __forceinline__ void kload2(bf16x8*kf,lds_cptr kp,int j){ kf[2*j]=*(const __attribute__((address_space(3))) bf16x8*)(kp+j*2048); kf[2*j+1]=*(const __attribute__((address_space(3))) bf16x8*)(kp+j*2048+512); }
__device__ __forceinline__ s16x4 vtr(lds_cptr p){ return __builtin_bit_cast(s16x4,__builtin_amdgcn_ds_read_tr16_b64_v4i16((__attribute__((address_space(3))) v4i16_t*)p)); }
__device__ __forceinline__ float rowmax(const f32x16&p0,const f32x16&p1){
  float a=max3f(p0[0],p0[1],p1[0]),b=max3f(p0[2],p0[3],p1[1]);a=max3f(a,p1[2],p1[3]);
  #pragma unroll
  for(int r=4;r<16;r+=4){a=max3f(a,p0[r],p0[r+1]);b=max3f(b,p0[r+2],p0[r+3]);a=max3f(a,p1[r],p1[r+1]);b=max3f(b,p1[r+2],p1[r+3]);}
  const float m=max2f(a,b);
  auto rr=__builtin_amdgcn_permlane32_swap(__float_as_uint(m),__float_as_uint(m),false,false);
  return max2f(__uint_as_float(rr[0]),__uint_as_float(rr[1]));
}
__device__ __forceinline__ void pv(f32x16*o,int vb,bf16x8 pa0,bf16x8 pa1,bf16x8 pa2,bf16x8 pa3){
  #pragma unroll
  for(int d0=0;d0<2;++d0){s16x4 lo[4],hi[4];
    #pragma unroll
    for(int ks=0;ks<4;++ks){
      asm volatile("ds_read_b64_tr_b16 %0,%1 offset:%c2":"=&v"(lo[ks]):"v"(vb),"i"(d0*4096+ks*1024):"memory");
      asm volatile("ds_read_b64_tr_b16 %0,%1 offset:%c2":"=&v"(hi[ks]):"v"(vb),"i"(d0*4096+ks*1024+512):"memory");}
    asm volatile("s_waitcnt lgkmcnt(0)":::"memory");SBAR();
    #define PK(k) (bf16x8){lo[k][0],lo[k][1],lo[k][2],lo[k][3],hi[k][0],hi[k][1],hi[k][2],hi[k][3]}
    o[d0]=__builtin_amdgcn_mfma_f32_32x32x16_bf16(pa0,PK(0),o[d0],0,0,0);
    o[d0]=__builtin_amdgcn_mfma_f32_32x32x16_bf16(pa1,PK(1),o[d0],0,0,0);
    o[d0]=__builtin_amdgcn_mfma_f32_32x32x16_bf16(pa2,PK(2),o[d0],0,0,0);
    o[d0]=__builtin_amdgcn_mfma_f32_32x32x16_bf16(pa3,PK(3),o[d0],0,0,0);
    #undef PK
  }
}

#ifndef ATTN_STORE16
#define ATTN_STORE16(p,v) (*(u32x4*)(p)=(v))
#endif
template<int THRL> __device__ __forceinline__ void attn_unit(long rowbase,int T,int h,int qb,const bf16*Z,bf16*O,char*shm){
  const int tid=threadIdx.x,lane=tid&63,r32=lane&31,hi=lane>>5; const int wid=__builtin_amdgcn_readfirstlane(tid>>6);
  const int q0=qb*QB;
  const bf16*Qw=Z+(rowbase+q0+wid*QBLK)*PZ+ZQ+h*D;
  const bf16*Kh=Z+rowbase*PZ+ZKA+(h>>2)*D,*Vh=Z+rowbase*PZ+ZVA+(h>>2)*D;
  const unsigned lds0=(unsigned)(uintptr_t)shm;
  float*wsf=(float*)(shm+LDS_WS)+wid*64;
  const bf16*ksrc=Kh+(long)lane*PZ+wid*8;
  const bf16*vsrc=Vh+(long)(16*(wid&3)+(lane>>2))*PZ+(wid>>2)*32+(lane&3)*8;
  const unsigned kdst=lds0+LDS_K+wid*1024, vdst=lds0+LDS_V+wid*1024;
  #define DMA_K(t,slot) glds16(ksrc+(long)(t)*KVBLK*PZ,(unsigned)__builtin_amdgcn_readfirstlane(kdst+(slot)))
  #define DMA_V(t,slot) glds16(vsrc+(long)(t)*KVBLK*PZ,(unsigned)__builtin_amdgcn_readfirstlane(vdst+(slot)))
  const int vb0=(int)(lds0+LDS_V)+((lane>>4)&1)*32+(lane&3)*8+(4*hi+((lane&15)>>2))*64;
  const char*Kbase=shm+LDS_K; bf16x8 kf[8];
  const lds_cptr shm3=(lds_cptr)shm; const lds_cptr kp0=shm3+LDS_K+hi*1024+r32*16; const lds_cptr vp0=shm3+LDS_V+((lane>>4)&1)*32+(lane&3)*8+(4*hi+((lane&15)>>2))*64;
  const int NT=T/KVBLK;
  DMA_K(0,0);DMA_V(0,0);DMA_K(1,SLOTB);
  bf16x8 qr[4];
  #pragma unroll
  for(int d0=0;d0<4;++d0)qr[d0]=*reinterpret_cast<const bf16x8*>(&Qw[(long)r32*PZ+d0*16+hi*8]);
  float mhat=0.f,l_reg=0.f;f32x16 o[2];o[0]=f32x16{};o[1]=f32x16{};f32x16 negm=f32x16{};asm volatile("":"+v"(negm));
  const int qrel=wid*QBLK+r32;
  #define CMASK(P0,P1,t) do{}while(0)
  bool resc=false;
  #define START(P0,P1) do{ const float rm=rowmax(P0,P1); resc=false; \
    { const float dl=rm; mhat=fadd_s(mhat,dl); \
      _Pragma("unroll") for(int r=0;r<16;++r){P0[r]=fsub_s(P0[r],dl);P1[r]=fsub_s(P1[r],dl);} \
      _Pragma("unroll") for(int r=0;r<16;++r)negm[r]=-mhat; asm volatile("":"+v"(negm)); } \
    _Pragma("unroll") for(int r=0;r<16;++r)P0[r]=__builtin_amdgcn_exp2f(P0[r]); }while(0)
  #define RESC() do{ if(resc){ asm volatile("s_waitcnt lgkmcnt(0)":::"memory"); \
      _Pragma("unroll") for(int d_=0;d_<2;++d_) _Pragma("unroll") for(int r=0;r<16;++r)o[d_][r]*=wsf[crow(r,hi)]; } }while(0)
  f32x16 pA0,pA1,pB0,pB1;
  int sl_prev=0,sl_cur=0,sl_next=SLOTB;
  #define ROT() do{sl_prev=sl_cur;sl_cur=sl_next;sl_next=(sl_next==(NSLOT-1)*SLOTB)?0:sl_next+SLOTB;}while(0)
  DMA_K(2,2*SLOTB);
  WAIT_BAR(3);
  qkt(pA0,pA1,Kbase,qr,negm,r32,hi);asm volatile("s_nop 15\n\ts_nop 7":"+v"(pA0),"+v"(pA1));CMASK(pA0,pA1,0);
  START(pA0,pA1);
  _Pragma("unroll") for(int r=0;r<16;++r)pA1[r]=__builtin_amdgcn_exp2f(pA1[r]);
  WAIT_BAR(0);
  DMA_K(3,0);DMA_V(1,SLOTB);
  ROT();
  kload8(kf,kp0+sl_cur);
  WAIT_BAR(2);
  s16x4 vlo[8],vhi[8]; u32x4 pw0,pw1,pw2,pw3;
  #define PKW(P,B) cvtpk_s(P[B],P[B+1])
  #define PAF(k) __builtin_bit_cast(bf16x8,pw##k)
  #define VFR(i) (bf16x8){vlo[i][0],vlo[i][1],vlo[i][2],vlo[i][3],vhi[i][0],vhi[i][1],vhi[i][2],vhi[i][3]}
  #define PIN(x) asm volatile("":"+v"(x))
  #define MX3(a,b,c) __builtin_fmaxf(__builtin_fmaxf((a),(b)),(c))
  #define GAPA(MF,A0,A1,A2,A3,W0,W1,PW) do{ MF; sacc+=A0; sacc+=A1; sacc+=A2; sacc+=A3; PIN(sacc); W0; W1; PIN(PW); SBAR(); }while(0)
  #define EX(v) __builtin_amdgcn_exp2f(v)
  #define GAPB(MF,X,B) do{ MF; X[B]=EX(X[B]); X[B+1]=EX(X[B+1]); X[B+2]=EX(X[B+2]); X[B+3]=EX(X[B+3]); PIN(X); SBAR(); }while(0)
  #define VRD(i) do{ vlo[i]=vtr(vp_+(((i)>>2)*4096+((i)&3)*1024)); vhi[i]=vtr(vp_+(((i)>>2)*4096+((i)&3)*1024+512)); }while(0)
  #define KRD(G,j) do{ if(G){ kload2(kf,kp0+sl_next,j); SBAR(); } }while(0)
  #define STEP(C0,C1,P0,P1,t,GK,GV,GL) do{ SBAR(); \
    const lds_cptr vp_=vp0+sl_prev; \
    VRD(0); SBAR(); float sacc=(P0[0]+P0[1]); \
    GAPA(C0=__builtin_amdgcn_mfma_f32_32x32x16_bf16(kf[0],qr[0],negm,0,0,0), P0[2],P0[3],P0[4],P0[5],     pw0[0]=PKW(P0,0), pw0[1]=PKW(P0,2), pw0); \
    VRD(4); SBAR(); GAPA(C1=__builtin_amdgcn_mfma_f32_32x32x16_bf16(kf[1],qr[0],negm,0,0,0), P0[6],P0[7],P0[8],P0[9],     pw0[2]=PKW(P0,4), pw0[3]=PKW(P0,6), pw0); \
    VRD(1); SBAR(); GAPA(C0=__builtin_amdgcn_mfma_f32_32x32x16_bf16(kf[2],qr[1],C0,0,0,0),   P0[10],P0[11],P0[12],P0[13], pw1[0]=PKW(P0,8), pw1[1]=PKW(P0,10), pw1); \
    VRD(5); SBAR(); GAPA(C1=__builtin_amdgcn_mfma_f32_32x32x16_bf16(kf[3],qr[1],C1,0,0,0),   P0[14],P0[15],P1[0],P1[1],   pw1[2]=PKW(P0,12),pw1[3]=PKW(P0,14), pw1); \
    VRD(2); SBAR(); GAPA(C0=__builtin_amdgcn_mfma_f32_32x32x16_bf16(kf[4],qr[2],C0,0,0,0),   P1[2],P1[3],P1[4],P1[5],     pw2[0]=PKW(P1,0), pw2[1]=PKW(P1,2), pw2); \
    VRD(6); SBAR(); GAPA(C1=__builtin_amdgcn_mfma_f32_32x32x16_bf16(kf[5],qr[2],C1,0,0,0),   P1[6],P1[7],P1[8],P1[9],     pw2[2]=PKW(P1,4), pw2[3]=PKW(P1,6), pw2); \
    VRD(3); SBAR(); GAPA(C0=__builtin_amdgcn_mfma_f32_32x32x16_bf16(kf[6],qr[3],C0,0,0,0),   P1[10],P1[11],P1[12],P1[13], pw3[0]=PKW(P1,8), pw3[1]=PKW(P1,10), pw3); \
    VRD(7); SBAR(); GAPA(C1=__builtin_amdgcn_mfma_f32_32x32x16_bf16(kf[7],qr[3],C1,0,0,0),   P1[14],P1[15],0.f,0.f,       pw3[2]=PKW(P1,12),pw3[3]=PKW(P1,14), pw3); \
    l_reg+=sacc; \
    if(GK){DMA_K((t)+3,sl_cur);} if(GV){DMA_V((t)+1,sl_next);} \
    CMASK(C0,C1,t); \
    { float a=MX3(C0[0],C0[1],C1[0]),b=MX3(C0[2],C0[3],C1[1]); a=MX3(a,C1[2],C1[3]); \
      _Pragma("unroll") for(int r=4;r<16;r+=4){a=MX3(a,C0[r],C0[r+1]);b=MX3(b,C0[r+2],C0[r+3]);a=MX3(a,C1[r],C1[r+1]);b=MX3(b,C1[r+2],C1[r+3]);} \
      float rm=__builtin_fmaxf(a,b); { auto rr=__builtin_amdgcn_permlane32_swap(__float_as_uint(rm),__float_as_uint(rm),false,false); rm=__builtin_fmaxf(__uint_as_float(rr[0]),__uint_as_float(rr[1])); } \
      resc=false; \
      if(__builtin_expect(__any(rm>(float)THRL),0)){ const float dl=__builtin_fmaxf(rm,0.f); mhat+=dl; \
        _Pragma("unroll") for(int r=0;r<16;++r){C0[r]-=dl;C1[r]-=dl;} \
        _Pragma("unroll") for(int r=0;r<16;++r)negm[r]=-mhat; asm volatile("":"+v"(negm)); \
        const float f=__builtin_amdgcn_exp2f(-dl); l_reg*=f; if(hi==0)wsf[r32]=f; resc=true; } } \
    SBAR(); \
    GAPB(o[0]=__builtin_amdgcn_mfma_f32_32x32x16_bf16(PAF(0),VFR(0),o[0],0,0,0), C0,0); \
    GAPB(o[1]=__builtin_amdgcn_mfma_f32_32x32x16_bf16(PAF(0),VFR(4),o[1],0,0,0), C0,4); \
    KRD(GL,0); GAPB(o[0]=__builtin_amdgcn_mfma_f32_32x32x16_bf16(PAF(1),VFR(1),o[0],0,0,0), C0,8); \
    KRD(GL,1); GAPB(o[1]=__builtin_amdgcn_mfma_f32_32x32x16_bf16(PAF(1),VFR(5),o[1],0,0,0), C0,12); \
    KRD(GL,2); GAPB(o[0]=__builtin_amdgcn_mfma_f32_32x32x16_bf16(PAF(2),VFR(2),o[0],0,0,0), C1,0); \
    KRD(GL,3); GAPB(o[1]=__builtin_amdgcn_mfma_f32_32x32x16_bf16(PAF(2),VFR(6),o[1],0,0,0), C1,4); \
    GAPB(o[0]=__builtin_amdgcn_mfma_f32_32x32x16_bf16(PAF(3),VFR(3),o[0],0,0,0), C1,8); \
    GAPB(o[1]=__builtin_amdgcn_mfma_f32_32x32x16_bf16(PAF(3),VFR(7),o[1],0,0,0), C1,12); \
    }while(0)
  int t=1;
  #undef CMASK
  #define CMASK(P0,P1,t) do{}while(0)
  for(;t+5<NT;t+=2){
    STEP(pB0,pB1,pA0,pA1,t,true,true,true);     WAIT_BAR(2); RESC(); ROT();
    STEP(pA0,pA1,pB0,pB1,t+1,true,true,true);   WAIT_BAR(2); RESC(); ROT();
  }
  #undef CMASK
  #define CMASK(P0,P1,t) do{}while(0)
  #define ENDW(tt) do{ if((tt)+3<NT){WAIT_BAR(2);} else if((tt)+2<NT){WAIT_BAR(1);} else {WAIT_BAR(0);} }while(0)
  for(;t+1<NT;t+=2){
    STEP(pB0,pB1,pA0,pA1,t,(t+3<NT),(t+1<NT),(t+1<NT));       ENDW(t);   RESC(); ROT();
    STEP(pA0,pA1,pB0,pB1,t+1,(t+4<NT),(t+2<NT),(t+2<NT));     ENDW(t+1); RESC(); ROT();
  }
  STEP(pB0,pB1,pA0,pA1,NT-1,false,false,false); RESC();
  { float sacc=pB0[0]+pB0[1]; _Pragma("unroll") for(int r=2;r<16;++r)sacc+=pB0[r]; _Pragma("unroll") for(int r=0;r<16;++r)sacc+=pB1[r]; l_reg+=sacc;
    pw0=(u32x4){PKW(pB0,0),PKW(pB0,2),PKW(pB0,4),PKW(pB0,6)};pw1=(u32x4){PKW(pB0,8),PKW(pB0,10),PKW(pB0,12),PKW(pB0,14)};pw2=(u32x4){PKW(pB1,0),PKW(pB1,2),PKW(pB1,4),PKW(pB1,6)};pw3=(u32x4){PKW(pB1,8),PKW(pB1,10),PKW(pB1,12),PKW(pB1,14)};
    SBAR(); pv(o,vb0+sl_cur,PAF(0),PAF(1),PAF(2),PAF(3)); }
  #undef PKW
  #undef PAF
  #undef VFR
  #undef PIN
  #undef MX3
  #undef GAPA
  #undef GAPB
  #undef EX
  #undef VRD
  #undef KRD
  #undef STEP
  #undef ENDW
  {auto rr=__builtin_amdgcn_permlane32_swap(__float_as_uint(l_reg),__float_as_uint(l_reg),false,false);l_reg=__uint_as_float(rr[0])+__uint_as_float(rr[1]);}
  if(hi==0)wsf[32+r32]=l_reg;asm volatile("s_waitcnt lgkmcnt(0)":::"memory");
  float rli[16];
  #pragma unroll
  for(int r=0;r<16;++r)rli[r]=__builtin_amdgcn_rcpf(wsf[32+crow(r,hi)]);
  bf16*Ow=O+(rowbase+q0+wid*QBLK)*PO+512+h*D;
  { bf16*stg=(bf16*)(shm+LDS_OST)+wid*2048;
    #pragma unroll
    for(int r=0;r<16;++r){const int orow=crow(r,hi);
      #pragma unroll
      for(int d0=0;d0<2;++d0)stg[orow*64+d0*32+r32]=__float2bfloat16(o[d0][r]*rli[r]);}
    asm volatile("s_waitcnt lgkmcnt(0)":::"memory");
    #pragma unroll
    for(int i=0;i<4;++i){const int row=i*8+(lane>>3),ch=lane&7; const u32x4 v=*(const u32x4*)(stg+row*64+ch*8); ATTN_STORE16(Ow+(long)row*PO+ch*8,v);} }
  asm volatile("s_waitcnt lgkmcnt(0)\n\ts_barrier":::"memory");
  #undef DMA_K
  #undef DMA_V
  #undef CMASK
  #undef START
  #undef RESC
  #undef ROT
}
constexpr int ATTN_LDS_BYTES=LDS_BYTES;
#undef SBAR
#undef WAIT_BAR
}
namespace cg = cooperative_groups;
#define LAS __attribute__((address_space(3)))
typedef unsigned short bf16;
typedef float f32x4 __attribute__((ext_vector_type(4)));
typedef float f32x2 __attribute__((ext_vector_type(2)));
typedef unsigned v4u __attribute__((ext_vector_type(4)));
typedef _Float16 f16x4 __attribute__((ext_vector_type(4)));
constexpr int NWAVES = 8, NTHR = 512;
constexpr int DMODEL = 1024, MP = 65536, MS = 32768, MTOT = 98304, TP = 2048, TS = 16384;
constexpr int PZ = 2816, NIN = 2688, DFF = 2816, KL = 384, NL = 2560;
constexpr int ZWF = 1536, ZQ = 1920;
constexpr size_t MiB = 1u << 20;
constexpr size_t WS_CTL = 0, CTL_ZERO_BYTES = 2 * MiB;
constexpr size_t WS_SSQ = 1 * MiB;
constexpr size_t WS_BIAS = 31 * MiB;
constexpr size_t WS_WIN = 2 * MiB, WS_WOUT = 8 * MiB, WS_WGU = 10 * MiB, WS_WDN = 22 * MiB, WS_WL = 28 * MiB;
constexpr size_t WS_Z = 32 * MiB;
constexpr size_t WS_A = 560 * MiB;
constexpr size_t WS_YCAT = 752 * MiB;
constexpr size_t WS_U = 944 * MiB;
constexpr size_t WS_END = 1024 * MiB;
constexpr int CW_QUEUE = 64;
constexpr int RING_BYTES = 131072, MISC_OFF = RING_BYTES + 320, LDS_BYTES = 147456;
constexpr int NPHASE = 10;

struct Params {
    const float* in[28]; float* out; unsigned char* ws; int ph_lo, ph_hi;
};

__device__ __forceinline__ unsigned pkbf(float lo, float hi) { return pg8::cvt_pk_bf16(lo, hi); }
__device__ __forceinline__ void cvt4bf(uint2 u, float (&o)[4]) { o[0] = __uint_as_float(u.x << 16); o[1] = __uint_as_float(u.x & 0xffff0000u); o[2] = __uint_as_float(u.y << 16); o[3] = __uint_as_float(u.y & 0xffff0000u); }
__device__ __forceinline__ uint2 pack4bf(const float (&v)[4]) { uint2 u; u.x = pkbf(v[0], v[1]); u.y = pkbf(v[2], v[3]); return u; }
__device__ __forceinline__ void cvt4h(uint2 u, float (&o)[4]) { f16x4 h = __builtin_bit_cast(f16x4, u); o[0] = (float)h[0]; o[1] = (float)h[1]; o[2] = (float)h[2]; o[3] = (float)h[3]; }
__device__ __forceinline__ float wave_sum(float v) {
#pragma unroll
    for (int o = 1; o < 64; o <<= 1) v += __shfl_xor(v, o);
    return v;
}
__device__ __forceinline__ float sum16(float v) { v += __shfl_xor(v, 1); v += __shfl_xor(v, 2); v += __shfl_xor(v, 4); v += __shfl_xor(v, 8); return v; }
__device__ __forceinline__ float dpp_x1(float x) { return __int_as_float(__builtin_amdgcn_mov_dpp(__float_as_int(x), 0xB1, 0xF, 0xF, true)); }
__device__ __forceinline__ float dpp_x2(float x) { return __int_as_float(__builtin_amdgcn_mov_dpp(__float_as_int(x), 0x4E, 0xF, 0xF, true)); }
__device__ __forceinline__ float dpp_hm(float x) { return __int_as_float(__builtin_amdgcn_mov_dpp(__float_as_int(x), 0x141, 0xF, 0xF, true)); }
__device__ __forceinline__ float sigm(float x) { return 1.0f / (1.0f + __expf(-x)); }

__device__ __forceinline__ void transpose_item(const float* W, int N, int k0, int n0, bf16* WT, int ldt, int dst_row0, int dst_k0, const float* kscale, LAS float* scr, int lane) {
#pragma unroll 8
    for (int i = 0; i < 32; ++i) { const int kk = 2 * i + (lane >> 5); float v = W[(size_t)(k0 + kk) * N + n0 + (lane & 31)]; if (kscale) v *= kscale[k0 + kk]; scr[kk * 33 + (lane & 31)] = v; }
    asm volatile("s_waitcnt lgkmcnt(0)" ::: "memory");
    const int c = lane & 7;
#pragma unroll
    for (int j = 0; j < 4; ++j) { const int n = (lane >> 3) + 8 * j; const LAS float* s = scr + (8 * c) * 33 + n;
        v4u o; o.x = pkbf(s[0 * 33], s[1 * 33]); o.y = pkbf(s[2 * 33], s[3 * 33]); o.z = pkbf(s[4 * 33], s[5 * 33]); o.w = pkbf(s[6 * 33], s[7 * 33]);
        *(v4u*)(WT + (size_t)(dst_row0 + n) * ldt + dst_k0 + 8 * c) = o; }
    asm volatile("s_waitcnt lgkmcnt(0)" ::: "memory");
}

__device__ __forceinline__ void p0_prologue(const Params& p, LAS unsigned char* lds) {
    const int tid = threadIdx.x, lane = tid & 63, wave = tid >> 6;
    LAS float* scr = (LAS float*)(lds + wave * 16384);
    const int gw = blockIdx.x * NWAVES + wave, NGW = gridDim.x * NWAVES;
    bf16* Win = (bf16*)(p.ws + WS_WIN); bf16* Wout = (bf16*)(p.ws + WS_WOUT); bf16* Wgu = (bf16*)(p.ws + WS_WGU); bf16* Wdn = (bf16*)(p.ws + WS_WDN); bf16* Wl = (bf16*)(p.ws + WS_WL);
    constexpr int I_IN = 16 * (NIN / 32), I_OUT = 16 * 32, I_G = 16 * (DFF / 32), I_DN = (DFF / 64) * 32;
    constexpr int NITEMS = I_IN + I_OUT + 2 * I_G + I_DN;
    for (int it = gw; it < NITEMS; it += NGW) {
        int r = it;
        if (r < I_IN) { const int nb = r % (NIN / 32), kb = r / (NIN / 32); transpose_item(p.in[3], NIN, 64 * kb, 32 * nb, Win, 1024, 32 * nb, 64 * kb, nullptr, scr, lane); continue; } r -= I_IN;
        if (r < I_OUT) { const int nb = r % 32, kb = r / 32; transpose_item(p.in[22], 1024, 64 * kb, 32 * nb, Wout, 1024, 32 * nb, 64 * kb, nullptr, scr, lane); continue; } r -= I_OUT;
        if (r < 2 * I_G) { const int up = r >= I_G; if (up) r -= I_G; const int nb = r % (DFF / 32), kb = r / (DFF / 32), n0 = 32 * nb;
            transpose_item(up ? p.in[25] : p.in[24], DFF, 64 * kb, n0, Wgu, 1024, 256 * (n0 >> 7) + (n0 & 127) + (up ? 128 : 0), 64 * kb, p.in[23], scr, lane); continue; } r -= 2 * I_G;
        { const int nb = r % 32, kb = r / 32; transpose_item(p.in[26], 1024, 64 * kb, 32 * nb, Wdn, DFF, 32 * nb, 64 * kb, nullptr, scr, lane); }
    }
    const int gt = blockIdx.x * NTHR + tid, NGT = gridDim.x * NTHR;
    for (int i = gt; i < 128 * 1024 / 8; i += NGT) *(v4u*)(Win + (size_t)NIN * 1024 + (size_t)i * 8) = (v4u){0u, 0u, 0u, 0u};
    for (int i = gt; i < NL * (KL / 8); i += NGT) {
        const int n = i / (KL / 8), c = i % (KL / 8), k = 8 * c, blk = n >> 9, nn = n & 511;
        const int ks = blk < 4 ? 64 * blk : 256, ke = blk < 4 ? ks + 64 : 384;
        v4u o = (v4u){0u, 0u, 0u, 0u};
        if (k >= ks && k < ke) {
            const float* src = p.in[blk == 0 ? 10 : blk == 1 ? 12 : blk == 2 ? 14 : blk == 3 ? 16 : 17] + (size_t)(k - ks) * 512 + nn;
            o.x = pkbf(src[0], src[512]); o.y = pkbf(src[1024], src[1536]); o.z = pkbf(src[2048], src[2560]); o.w = pkbf(src[3072], src[3584]);
        }
        *(v4u*)(Wl + (size_t)n * KL + k) = o;
    }
    bf16* XN = (bf16*)(p.ws + WS_A); const float* g1 = p.in[2];
    f32x4 gv[4];
#pragma unroll
    for (int j = 0; j < 4; ++j) gv[j] = *((const f32x4*)g1 + lane + 64 * j);
    for (int m = gw; m < MTOT; m += NGW) {
        const float* xrow = (m < MP) ? p.in[0] + (size_t)m * 1024 : p.in[1] + (size_t)(m - MP) * 1024;
        const f32x4* xr = (const f32x4*)xrow + lane; f32x4 v[4]; float s = 0.f;
#pragma unroll
        for (int j = 0; j < 4; ++j) { v[j] = xr[64 * j]; s += (v[j].x * v[j].x + v[j].y * v[j].y) + (v[j].z * v[j].z + v[j].w * v[j].w); }
        const float rstd = 1.0f / sqrtf(wave_sum(s) * (1.0f / 1024.0f) + 1e-6f);
        uint2* o8 = (uint2*)(XN + (size_t)m * 1024) + lane;
#pragma unroll
        for (int j = 0; j < 4; ++j) { uint2 o; o.x = pkbf(v[j].x * rstd * gv[j].x, v[j].y * rstd * gv[j].y); o.y = pkbf(v[j].z * rstd * gv[j].z, v[j].w * rstd * gv[j].w); o8[64 * j] = o; }
    }
}

__device__ __forceinline__ void p2_prep(const Params& p) {
    const int tid = threadIdx.x, lane = tid & 63, wave = tid >> 6;
    const int gw = blockIdx.x * NWAVES + wave, NGW = gridDim.x * NWAVES;
    bf16* Z = (bf16*)(p.ws + WS_Z); bf16* U = (bf16*)(p.ws + WS_U);
    const float* mup = p.in[4]; const float* mun = p.in[5]; const float* qg = p.in[20]; const float* kg = p.in[21];
    const int l = lane & 15, hq = lane >> 4;
    float gq[4], gk[4], inv[4];
#pragma unroll
    for (int i = 0; i < 4; ++i) { gq[i] = qg[4 * l + i]; gk[i] = kg[4 * l + i]; inv[i] = exp2f(-(float)(4 * (l & 3) + i) * (13.287712379549449f / 16.0f)); }
    float mp0[4], mn0[4], mp1[4], mn1[4];
#pragma unroll
    for (int i = 0; i < 4; ++i) { mp0[i] = mup[ZWF + 4 * lane + i]; mn0[i] = mun[ZWF + 4 * lane + i]; const int c1 = ZWF + 256 + 4 * (lane & 31) + i; mp1[i] = mup[c1]; mn1[i] = mun[c1]; }
    for (int m = gw; m < MTOT; m += NGW) {
        int t; int T;
        if (m < MP) { t = m & (TP - 1); T = TP; } else { t = (m - MP) & (TS - 1); T = TS; }
        const float prow = (float)(t >> 6), pcol = (float)(t & 63);
        bf16* zrow = Z + (size_t)m * PZ;
#pragma unroll
        for (int ps = 0; ps < 3; ++ps) {
            const int head = ps * 4 + hq; const bool act = head < 10; const int hd = act ? head : 9;
            bf16* ptr = zrow + ZQ + hd * 64 + 4 * l;
            float x[4]; cvt4bf(*(const uint2*)ptr, x);
            float ss = (x[0] * x[0] + x[1] * x[1]) + (x[2] * x[2] + x[3] * x[3]); ss = sum16(ss);
            const float rstd = 1.0f / sqrtf(ss * (1.0f / 64.0f) + 1e-6f);
            const float pos = (l & 8) ? pcol : prow; const bool first = !(l & 4);
            float o[4];
#pragma unroll
            for (int i = 0; i < 4; ++i) {
                const float xn = x[i] * rstd * (hd < 8 ? gq[i] : gk[i]);
                const float pr = __shfl_xor(xn, 4);
                const float ang = pos * inv[i];
                const float nr = rintf(ang * 0.15915494309189535f);
                float rr = fmaf(-nr, 6.2831855f, ang); rr = fmaf(-nr, -1.7484555e-7f, rr);
                const float sn = __sinf(rr), cs = __cosf(rr);
                float v = first ? (xn * cs - pr * sn) : (xn * cs + pr * sn);
                if (hd < 8) v *= 0.18033688011112042f;
                o[i] = v;
            }
            if (act) *(uint2*)ptr = pack4bf(o);
        }
        {
            const bf16* zc = zrow + ZWF + 4 * lane;
            float z[4], zp[4] = {0.f, 0.f, 0.f, 0.f}, zn[4] = {0.f, 0.f, 0.f, 0.f};
            cvt4bf(*(const uint2*)zc, z); if (t > 0) cvt4bf(*(const uint2*)(zc - PZ), zp); if (t < T - 1) cvt4bf(*(const uint2*)(zc + PZ), zn);
            float o[4];
#pragma unroll
            for (int i = 0; i < 4; ++i) { const float zf = z[i] + mp0[i] * (zp[i] - z[i]) + mn0[i] * (zn[i] - z[i]); o[i] = (lane < 32) ? (1.0f - 2.0f / (1.0f + __expf(2.0f * zf))) : zf; }
            *(uint2*)(U + (size_t)m * KL + 4 * lane) = pack4bf(o);
        }
        if (lane < 32) {
            const bf16* zc = zrow + ZWF + 256 + 4 * lane;
            float z[4], zp[4] = {0.f, 0.f, 0.f, 0.f}, zn[4] = {0.f, 0.f, 0.f, 0.f};
            cvt4bf(*(const uint2*)zc, z); if (t > 0) cvt4bf(*(const uint2*)(zc - PZ), zp); if (t < T - 1) cvt4bf(*(const uint2*)(zc + PZ), zn);
            float o[4];
#pragma unroll
            for (int i = 0; i < 4; ++i) { const float zf = z[i] + mp1[i] * (zp[i] - z[i]) + mn1[i] * (zn[i] - z[i]); o[i] = sigm(zf); }
            *(uint2*)(U + (size_t)m * KL + 256 + 4 * lane) = pack4bf(o);
        }
    }
}

constexpr int TC = 32;
__device__ __forceinline__ void scan_unit(const Params& p, LAS unsigned char* lds, int chain) {
    const int tid = threadIdx.x, lane = tid & 63, wv = tid >> 6;
    int cc = chain; long seqbase; int T;
    if (cc < 32) { seqbase = MP + (long)(cc >> 4) * TS; T = TS; } else { cc -= 32; seqbase = (long)(cc >> 4) * TP; T = TP; }
    const int h = (cc >> 1) & 7, dir = cc & 1;
    const int tk = tid >> 4, l = tid & 15, hc = h * 64 + 4 * l;
    const bf16* Z = (const bf16*)(p.ws + WS_Z);
    const _Float16* LAM = (const _Float16*)p.out + (size_t)dir * MTOT * 512;
    const _Float16* AR = (const _Float16*)p.out + (size_t)(2 + dir) * MTOT * 512;
    bf16* YF = (bf16*)(p.ws + WS_YCAT); bf16* YB = (bf16*)(p.ws + WS_A);
    float mupv[3][4], munv[3][4], kkc[4], kac[4], w0c[4], a0c[4];
#pragma unroll
    for (int q = 0; q < 3; ++q)
#pragma unroll
        for (int i = 0; i < 4; ++i) { mupv[q][i] = p.in[4][q * 512 + hc + i]; munv[q][i] = p.in[5][q * 512 + hc + i]; }
#pragma unroll
    for (int i = 0; i < 4; ++i) { kkc[i] = p.in[6][hc + i]; kac[i] = p.in[7][hc + i]; w0c[i] = p.in[dir ? 11 : 9][hc + i]; a0c[i] = p.in[dir ? 15 : 13][hc + i]; }
    LAS float* bufs = (LAS float*)lds;
    LAS float* ybufs = bufs + 2 * 6 * TC * 64;
    f32x2 S[4];
#pragma unroll
    for (int i = 0; i < 4; ++i) S[i] = (f32x2){0.f, 0.f};
    const int j = lane & 7, srow = wv * 8 + (lane >> 3);
    const int nch = T / TC;
    uint2 rz[3][3]; uint2 rl, ra;
    for (int c = -1; c < nch; ++c) {
        const bool more = (c + 1 < nch);
        if (more) {
            const int sidx = (c + 1) * TC + tk, t = dir ? (T - 1 - sidx) : sidx; const long row = seqbase + t;
            const bf16* zr = Z + (size_t)row * PZ + hc;
#pragma unroll
            for (int q = 0; q < 3; ++q) {
                rz[q][1] = *(const uint2*)(zr + q * 512);
                rz[q][0] = (t > 0) ? *(const uint2*)(zr + q * 512 - PZ) : (uint2){0u, 0u};
                rz[q][2] = (t < T - 1) ? *(const uint2*)(zr + q * 512 + PZ) : (uint2){0u, 0u};
            }
            rl = *(const uint2*)(LAM + (size_t)row * 512 + hc); ra = *(const uint2*)(AR + (size_t)row * 512 + hc);
        }
        if (c >= 0) {
            const LAS float* B = bufs + (c & 1) * 6 * TC * 64; LAS float* Y = ybufs + (c & 1) * TC * 64;
#pragma unroll 2
            for (int s = 0; s < TC; ++s) {
                const LAS float* q = B + s * 64 + 8 * j;
                const f32x4 w0 = *(const LAS f32x4*)(q), w1 = *(const LAS f32x4*)(q + 4);
                const f32x4 a0 = *(const LAS f32x4*)(q + 2048), a1 = *(const LAS f32x4*)(q + 2048 + 4);
                const f32x4 b0 = *(const LAS f32x4*)(q + 4096), b1 = *(const LAS f32x4*)(q + 4096 + 4);
                const f32x4 k0 = *(const LAS f32x4*)(q + 6144), k1 = *(const LAS f32x4*)(q + 6144 + 4);
                const f32x4 r0 = *(const LAS f32x4*)(q + 8192), r1 = *(const LAS f32x4*)(q + 8192 + 4);
                const float vv = B[10240 + s * 64 + srow];
                const f32x2 A[4] = {{a0.x, a0.y}, {a0.z, a0.w}, {a1.x, a1.y}, {a1.z, a1.w}};
                const f32x2 W[4] = {{w0.x, w0.y}, {w0.z, w0.w}, {w1.x, w1.y}, {w1.z, w1.w}};
                const f32x2 Bv[4] = {{b0.x, b0.y}, {b0.z, b0.w}, {b1.x, b1.y}, {b1.z, b1.w}};
                const f32x2 KD[4] = {{k0.x, k0.y}, {k0.z, k0.w}, {k1.x, k1.y}, {k1.z, k1.w}};
                const f32x2 R[4] = {{r0.x, r0.y}, {r0.z, r0.w}, {r1.x, r1.y}, {r1.z, r1.w}};
                f32x2 p0 = S[0] * A[0], p1 = S[1] * A[1]; p0 = S[2] * A[2] + p0; p1 = S[3] * A[3] + p1; p0 = p0 + p1;
                float sa = p0.x + p0.y; sa += dpp_x1(sa); sa += dpp_x2(sa); sa += dpp_hm(sa);
                const f32x2 vv2 = {vv, vv}, sa2 = {sa, sa};
#pragma unroll
                for (int i = 0; i < 4; ++i) { const f32x2 qq = S[i] * W[i] + KD[i] * vv2; S[i] = sa2 * Bv[i] + qq; }
                f32x2 y0 = S[0] * R[0], y1 = S[1] * R[1]; y0 = S[2] * R[2] + y0; y1 = S[3] * R[3] + y1; y0 = y0 + y1;
                float y = y0.x + y0.y; y += dpp_x1(y); y += dpp_x2(y); y += dpp_hm(y);
                if (j == 0) Y[s * 64 + srow] = y;
            }
        }
        if (more) {
            float r[4], k[4], v[4], lam[4], ar[4];
            {
                float z[4], zp[4], zn[4];
                cvt4bf(rz[0][1], z); cvt4bf(rz[0][0], zp); cvt4bf(rz[0][2], zn);
#pragma unroll
                for (int i = 0; i < 4; ++i) r[i] = z[i] + mupv[0][i] * (zp[i] - z[i]) + munv[0][i] * (zn[i] - z[i]);
                cvt4bf(rz[1][1], z); cvt4bf(rz[1][0], zp); cvt4bf(rz[1][2], zn);
#pragma unroll
                for (int i = 0; i < 4; ++i) k[i] = z[i] + mupv[1][i] * (zp[i] - z[i]) + munv[1][i] * (zn[i] - z[i]);
                cvt4bf(rz[2][1], z); cvt4bf(rz[2][0], zp); cvt4bf(rz[2][2], zn);
#pragma unroll
                for (int i = 0; i < 4; ++i) v[i] = z[i] + mupv[2][i] * (zp[i] - z[i]) + munv[2][i] * (zn[i] - z[i]);
            }
            cvt4h(rl, lam); cvt4h(ra, ar);
#pragma unroll
            for (int i = 0; i < 4; ++i) { lam[i] = 0.60653066f * sigm(lam[i] + w0c[i]); ar[i] = sigm(ar[i] + a0c[i]); }
            float kkv[4]; float ss = 0.f;
#pragma unroll
            for (int i = 0; i < 4; ++i) { kkv[i] = k[i] * kkc[i]; ss += kkv[i] * kkv[i]; }
            ss = sum16(ss);
            const float inv = 1.0f / sqrtf(fmaxf(ss, 1e-12f));
            f32x4 ow, oa, ob, ok, orr, ov;
#pragma unroll
            for (int i = 0; i < 4; ++i) {
                const float kn = kkv[i] * inv;
                ow[i] = __expf(-lam[i]); oa[i] = -kn; ob[i] = kn * ar[i]; ok[i] = k[i] * (1.0f + (ar[i] - 1.0f) * kac[i]); orr[i] = r[i]; ov[i] = v[i];
            }
            LAS float* D = bufs + ((c + 1) & 1) * 6 * TC * 64 + tk * 64 + 4 * l;
            *(LAS f32x4*)(D) = ow; *(LAS f32x4*)(D + 2048) = oa; *(LAS f32x4*)(D + 4096) = ob; *(LAS f32x4*)(D + 6144) = ok; *(LAS f32x4*)(D + 8192) = orr; *(LAS f32x4*)(D + 10240) = ov;
        }
        __syncthreads();
        if (c >= 0) {
            const int sidx = c * TC + tk, t = dir ? (T - 1 - sidx) : sidx; const long row = seqbase + t;
            const f32x4 y4 = *(const LAS f32x4*)(ybufs + (c & 1) * TC * 64 + tk * 64 + 4 * l);
            uint2 o; o.x = pkbf(y4.x, y4.y); o.y = pkbf(y4.z, y4.w);
            if (dir == 0) *(uint2*)(YF + (size_t)row * 1024 + hc) = o; else *(uint2*)(YB + (size_t)row * 512 + hc) = o;
        }
    }
    __syncthreads();
}

__device__ __forceinline__ void p5_post(const Params& p) {
    const int tid = threadIdx.x, lane = tid & 63, wave = tid >> 6;
    const int gw = blockIdx.x * NWAVES + wave, NGW = gridDim.x * NWAVES;
    const bf16* Z = (const bf16*)(p.ws + WS_Z);
    const _Float16* ARF = (const _Float16*)p.out + (size_t)2 * MTOT * 512; const _Float16* ARB = (const _Float16*)p.out + (size_t)3 * MTOT * 512;
    bf16* YC = (bf16*)(p.ws + WS_YCAT); const bf16* YB = (const bf16*)(p.ws + WS_A); const _Float16* G = (const _Float16*)(p.ws + WS_A) + (size_t)MTOT * 512;
    const int l = lane & 15, hq = lane >> 4;
    for (int it = gw; it < MTOT * 2; it += NGW) {
        const int m = it >> 1, h = (it & 1) * 4 + hq, hc = h * 64 + 4 * l;
        int t, T; if (m < MP) { t = m & (TP - 1); T = TP; } else { t = (m - MP) & (TS - 1); T = TS; }
        float yf[4], yb[4], gg[4], af[4], ab[4];
        cvt4bf(*(const uint2*)(YC + (size_t)m * 1024 + hc), yf); cvt4bf(*(const uint2*)(YB + (size_t)m * 512 + hc), yb); cvt4h(*(const uint2*)(G + (size_t)m * 512 + hc), gg);
        cvt4h(*(const uint2*)(ARF + (size_t)m * 512 + hc), af); cvt4h(*(const uint2*)(ARB + (size_t)m * 512 + hc), ab);
        { const f32x4 a0f = *(const f32x4*)(p.in[13] + hc), a0b = *(const f32x4*)(p.in[15] + hc);
#pragma unroll
          for (int i = 0; i < 4; ++i) { af[i] = sigm(af[i] + a0f[i]); ab[i] = sigm(ab[i] + a0b[i]); } }
        float rkv[3][4];
        const bf16* zr = Z + (size_t)m * PZ + hc;
#pragma unroll
        for (int q = 0; q < 3; ++q) {
            float z[4], zp[4] = {0.f, 0.f, 0.f, 0.f}, zn[4] = {0.f, 0.f, 0.f, 0.f};
            cvt4bf(*(const uint2*)(zr + q * 512), z); if (t > 0) cvt4bf(*(const uint2*)(zr + q * 512 - PZ), zp); if (t < T - 1) cvt4bf(*(const uint2*)(zr + q * 512 + PZ), zn);
            const f32x4 mp = *(const f32x4*)(p.in[4] + q * 512 + hc), mn = *(const f32x4*)(p.in[5] + q * 512 + hc);
#pragma unroll
            for (int i = 0; i < 4; ++i) rkv[q][i] = z[i] + mp[i] * (zp[i] - z[i]) + mn[i] * (zn[i] - z[i]);
        }
        const f32x4 ka = *(const f32x4*)(p.in[7] + hc), rk = *(const f32x4*)(p.in[8] + hc), lw = *(const f32x4*)(p.in[18] + hc), lb = *(const f32x4*)(p.in[19] + hc);
        float y[4]; float s = 0.f, bs = 0.f;
#pragma unroll
        for (int i = 0; i < 4; ++i) { y[i] = yf[i] + yb[i]; s += y[i]; const float kb = rkv[1][i] * (1.0f + (0.5f * (af[i] + ab[i]) - 1.0f) * ka[i]); bs += rkv[0][i] * kb * rk[i]; }
        s = sum16(s); bs = sum16(bs);
        const float mean = s * (1.0f / 64.0f); float q2 = 0.f;
#pragma unroll
        for (int i = 0; i < 4; ++i) { y[i] -= mean; q2 += y[i] * y[i]; }
        q2 = sum16(q2);
        const float rstd = 1.0f / sqrtf(q2 * (1.0f / 64.0f) + 64e-5f);
        float o[4];
#pragma unroll
        for (int i = 0; i < 4; ++i) o[i] = (y[i] * rstd * lw[i] + lb[i] + bs * rkv[2][i]) * gg[i];
        *(uint2*)(YC + (size_t)m * 1024 + hc) = pack4bf(o);
    }
}

__device__ __forceinline__ void p9_final(const Params& p) {
    const int tid = threadIdx.x, lane = tid & 63, wave = tid >> 6;
    const int gw = blockIdx.x * NWAVES + wave, NGW = gridDim.x * NWAVES;
    f32x4 gv[4];
#pragma unroll
    for (int j = 0; j < 4; ++j) gv[j] = *((const f32x4*)p.in[27] + lane + 64 * j);
    for (int m = gw; m < MTOT; m += NGW) {
        f32x4* xr = (f32x4*)(p.out + (size_t)m * 1024) + lane; f32x4 v[4]; float s = 0.f;
#pragma unroll
        for (int j = 0; j < 4; ++j) { v[j] = xr[64 * j]; s += (v[j].x * v[j].x + v[j].y * v[j].y) + (v[j].z * v[j].z + v[j].w * v[j].w); }
        const float rstd = 1.0f / sqrtf(wave_sum(s) * (1.0f / 1024.0f) + 1e-6f);
#pragma unroll
        for (int j = 0; j < 4; ++j) xr[64 * j] = v[j] * rstd * gv[j];
    }
}

constexpr int N_SCAN_S = 32, N_SCAN_P = 512, N_ATT_S = 2 * 8 * (TS / 256), N_ATT_P = 32 * 8 * (TP / 256);
constexpr int N_UNITS = N_SCAN_S + N_SCAN_P + N_ATT_S + N_ATT_P;

__global__ void __launch_bounds__(NTHR, 2) mega_fwd(Params p) {
    extern __shared__ __attribute__((aligned(16))) unsigned char lds_raw[];
    LAS unsigned char* lds = (LAS unsigned char*)lds_raw;
    volatile LAS unsigned* MISC = (volatile LAS unsigned*)(lds + MISC_OFF);
    const int tid = threadIdx.x;
    const int lo = p.ph_lo, hi = p.ph_hi;
    unsigned char* ws = p.ws;
    bf16* Zb = (bf16*)(ws + WS_Z); bf16* Ab = (bf16*)(ws + WS_A); bf16* YC = (bf16*)(ws + WS_YCAT);
    float* ssq2 = (float*)(ws + WS_SSQ);
#define IN(k) (lo <= (k) && (k) < hi)
#define SEAM(k) do { if (IN(k) && IN((k) + 1)) { cg::this_grid().sync(); } } while (0)
    if (IN(0)) { p0_prologue(p, lds); __syncthreads(); }
    SEAM(0);
#ifndef NOP1
    if (IN(1)) {
        pg8::Gemm g{Ab, (const bf16*)(ws + WS_WIN), MTOT, PZ, 1024}; pg8::StaticOrder S; S.init(MTOT, PZ, gridDim.x, (int)blockIdx.x);
        pg8::EpiBf16<0> E{Zb, PZ, nullptr, 0, 0, 1.f};
        pg8::gemm_phase<pg8::EpiBf16<0>, pg8::StaticOrder, true, true>(lds, g, S, E);
    }
#endif
    SEAM(1);
    if (IN(2)) p2_prep(p);
    SEAM(2);
#ifndef NOP3
    if (IN(3)) {
        pg8::Gemm g{(const bf16*)(ws + WS_U), (const bf16*)(ws + WS_WL), MTOT, NL, KL}; pg8::StaticOrder S; S.init(MTOT, NL, gridDim.x, (int)blockIdx.x);
        pg8::EpiLora E{(_Float16*)p.out, (size_t)MTOT * 512, (_Float16*)(Ab + (size_t)MTOT * 512)};
        pg8::gemm_phase<pg8::EpiLora, pg8::StaticOrder, true, true>(lds, g, S, E);
    }
#endif
    SEAM(3);
    if (IN(4)) {
        unsigned* qctr = (unsigned*)(ws + WS_CTL) + CW_QUEUE;
        for (;;) {
            if (tid == 0) MISC[0] = atomicAdd(qctr, 1u);
            __syncthreads();
            const int u = (int)MISC[0];
            __syncthreads();
            if (u >= N_UNITS) break;
#ifndef NOSCAN
            if (u < N_SCAN_S + N_SCAN_P) { scan_unit(p, lds, u); } else
#endif
            {
#ifndef NOATT
                int a = u - (N_SCAN_S + N_SCAN_P); long rowbase; int T, nqb;
                if (a < N_ATT_S) { T = TS; nqb = TS / 256; } else { a -= N_ATT_S; T = TP; nqb = TP / 256; }
                const int gq = a & 3, qb = (a >> 2) % nqb, rest = (a >> 2) / nqb, kvh = rest & 1, seq = rest >> 1;
                rowbase = (T == TS) ? (long)MP + (long)seq * TS : (long)seq * TP;
                attn_body::attn_unit<8>(rowbase, T, kvh * 4 + gq, qb, (const attn_body::bf16*)(const void*)Zb, (attn_body::bf16*)(void*)YC, (char*)lds_raw);
#endif
            }
        }
    }
    SEAM(4);
    if (IN(5)) p5_post(p);
    SEAM(5);
#ifndef NOP6
    if (IN(6)) {
        pg8::Gemm g{YC, (const bf16*)(ws + WS_WOUT), MTOT, 1024, 1024}; pg8::StaticOrder S; S.init(MTOT, 1024, gridDim.x, (int)blockIdx.x);
        pg8::EpiRes<true> E{p.in[0], p.in[1], p.out, Ab, ssq2};
        pg8::gemm_phase<pg8::EpiRes<true>, pg8::StaticOrder, true, true>(lds, g, S, E);
    }
#endif
    SEAM(6);
#ifndef NOP7
    if (IN(7)) {
        pg8::Gemm g{Ab, (const bf16*)(ws + WS_WGU), MTOT, 2 * DFF, 1024}; pg8::StaticOrder S; S.init(MTOT, 2 * DFF, gridDim.x, (int)blockIdx.x);
        pg8::EpiSwiGLU E{Zb, ssq2};
        pg8::gemm_phase<pg8::EpiSwiGLU, pg8::StaticOrder, true, true>(lds, g, S, E);
    }
#endif
    SEAM(7);
#ifndef NOP8
    if (IN(8)) {
        pg8::Gemm g{Zb, (const bf16*)(ws + WS_WDN), MTOT, 1024, DFF}; pg8::StaticOrder S; S.init(MTOT, 1024, gridDim.x, (int)blockIdx.x);
        pg8::EpiRes<false> E{p.out, p.out + (size_t)MP * 1024, p.out, nullptr, nullptr};
        pg8::gemm_phase<pg8::EpiRes<false>, pg8::StaticOrder, true, true>(lds, g, S, E);
    }
#endif
    SEAM(8);
    if (IN(9)) p9_final(p);
#undef IN
#undef SEAM
}

extern "C" void kernel_launch(void* const* d_in, const int* in_sizes, int n_in, void* d_out, int out_size, void* d_ws, size_t ws_size, hipStream_t stream) {
    static int grid = 0;
    if (grid == 0) {
        if (n_in != 28 || out_size != MTOT * 1024 || ws_size < WS_END) { fprintf(stderr, "kernel_launch: unexpected shapes n_in %d out %d ws %zu\n", n_in, out_size, ws_size); grid = -1; return; }
        int dev = 0, cus = 0, per_cu = 0;
        hipGetDevice(&dev); hipDeviceGetAttribute(&cus, hipDeviceAttributeMultiprocessorCount, dev);
        if (hipFuncSetAttribute((const void*)mega_fwd, hipFuncAttributeMaxDynamicSharedMemorySize, LDS_BYTES) != hipSuccess) { fprintf(stderr, "kernel_launch: hipFuncSetAttribute failed\n"); grid = -1; return; }
        if (hipOccupancyMaxActiveBlocksPerMultiprocessor(&per_cu, (const void*)mega_fwd, NTHR, LDS_BYTES) != hipSuccess || per_cu < 1) { fprintf(stderr, "kernel_launch: occupancy query says %d\n", per_cu); per_cu = 1; }
        (void)hipGetLastError();
        grid = cus * 1;
    }
    if (grid < 0) return;
    hipMemsetAsync((char*)d_ws + WS_CTL, 0, CTL_ZERO_BYTES, stream);
    Params p{};
    for (int i = 0; i < 28; ++i) p.in[i] = (const float*)d_in[i];
    p.out = (float*)d_out; p.ws = (unsigned char*)d_ws;
#if MK_N_LAUNCHES == 1
    p.ph_lo = 0; p.ph_hi = NPHASE;
    void* args[] = {&p};
    hipError_t e = hipLaunchCooperativeKernel((const void*)mega_fwd, dim3(grid), dim3(NTHR), args, LDS_BYTES, stream);
    if (e != hipSuccess) fprintf(stderr, "cooperative launch failed: %s (grid %d)\n", hipGetErrorString(e), grid);
#else
    for (int ph = 0; ph < NPHASE; ++ph) {
        p.ph_lo = ph; p.ph_hi = ph + 1;
        hipLaunchKernelGGL(mega_fwd, dim3(grid), dim3(NTHR), LDS_BYTES, stream, p);
    }
#endif
}
```

```cpp
#include <hip/hip_runtime.h>
#include <hip/hip_cooperative_groups.h>
#include <cstdio>
#include <cstdint>
#ifndef MK_N_LAUNCHES
#define MK_N_LAUNCHES 1
#endif
namespace pg8 {
#define PG8_LAS __attribute__((address_space(3)))
typedef unsigned short bf16_t;
typedef short bf16x8 __attribute__((ext_vector_type(8)));
typedef float f32x4 __attribute__((ext_vector_type(4)));
typedef unsigned u32x4 __attribute__((ext_vector_type(4)));
constexpr int BM = 256, BK = 64, HALF = 128, HTB = HALF * BK * 2  , STAGE_BYTES = 8 * HTB, NXCD = 8, WGM = 8;

__host__ __device__ __forceinline__ int lds_byte(int r, int c) { const int st = (r >> 4) * 2 + (c >> 5), rr = r & 15, cc = c & 31, ob = rr * 64 + cc * 2; return st * 1024 + (ob ^ (((ob >> 9) & 1) << 5)); }
__host__ __device__ __forceinline__ void stage_rc(int b, int& R, int& C) { const int st = b / 1024, sb = b % 1024, swz = sb ^ (((sb >> 9) & 1) << 5); R = (st >> 1) * 16 + swz / 64; C = (st & 1) * 32 + (swz % 64) / 2; }
__host__ __device__ __forceinline__ int perm32(int rho) { const int n = rho >> 4, i = rho & 15; return 8 * (i >> 2) + 4 * n + (i & 3); }

struct Unit { int pm, pn; };
struct Gemm { const bf16_t* A; const bf16_t* Bt; int M, N, K; int lda; int acs; };

struct StaticOrder {
    int nM, nN, nwg, G, c;
    __host__ __device__ void init(int M, int N, int G_, int c_) { nM = M / BM; nN = N / BM; nwg = nM * nN; G = G_; c = c_; }
    __host__ __device__ bool next(int i, Unit& u) const {
        const long L = (long)i * G + c; if (L >= nwg) return false;
        int wgid = (int)L; { const int q = nwg / NXCD, r = nwg % NXCD, xcd = wgid % NXCD, off = wgid / NXCD; wgid = (xcd < r ? xcd * (q + 1) : r * (q + 1) + (xcd - r) * q) + off; }
        const int nig = WGM * nN, gid = wgid / nig, fm = gid * WGM, gsz = (nM - fm) < WGM ? (nM - fm) : WGM;
        u.pm = fm + ((wgid % nig) % gsz); u.pn = (wgid % nig) / gsz; return true;
    }
    __device__ __forceinline__ void a_ready(const Unit&) const {}
    __device__ __forceinline__ void done(const Unit&) const {}
};

__device__ __forceinline__ unsigned cvt_pk_bf16(float lo, float hi) { unsigned r; asm volatile("v_cvt_pk_bf16_f32 %0, %1, %2" : "=v"(r) : "v"(lo), "v"(hi)); return r; }
typedef float f32x2 __attribute__((ext_vector_type(2)));
__device__ __forceinline__ f32x2 gelu_pk(f32x2 v) {
    const f32x2 av = __builtin_elementwise_abs(v), d = av * 0.2316418882f + 1.0f;
    f32x2 t; t.x = __builtin_amdgcn_rcpf(d.x); t.y = __builtin_amdgcn_rcpf(d.y);
    f32x2 q = t * 0.5307027145f + (-0.7265760135f); q = q * t + 0.7107068705f; q = q * t + (-0.142248368f); q = q * t + 0.127414796f; q = q * t;
    const f32x2 s = (v * v) * (-0.72134752044f);
    f32x2 e; e.x = __builtin_amdgcn_exp2f(s.x); e.y = __builtin_amdgcn_exp2f(s.y);
    const f32x2 m = v * (q * e), r = v - m;
    f32x2 o; o.x = v.x < 0.f ? m.x : r.x; o.y = v.y < 0.f ? m.y : r.y; return o;
}

template <int ACT  > struct EpiBf16 {
    static constexpr bool PERM = true, AFTER_DRAIN = false; static_assert(ACT == 0 || ACT == 1, "EpiBf16: ACT is 0 (none) or 1 (gelu_pk)");
    bf16_t* O; int ldc; const float* bias; int split_cols; size_t split_stride; float scale0;
    __device__ __forceinline__ void operator()(const f32x4 (&acc)[2][2][4][2], const Unit& u, int wr, int wc, int fr, int fq) const {
        const int row0 = u.pm * BM + wr * 64 + fr; int colt = u.pn * BM; bf16_t* base = O;
        float sc = 1.f; if (split_cols) { const int t = colt / split_cols; base += (size_t)t * split_stride; colt -= t * split_cols; if (t == 0) sc = scale0; }
        const int col0 = colt + wc * 32 + 8 * fq, bcol0 = u.pn * BM + wc * 32 + 8 * fq;
        f32x4 bv[2][2];
#pragma unroll
        for (int bj = 0; bj < 2; ++bj)
#pragma unroll
            for (int n = 0; n < 2; ++n) bv[bj][n] = bias ? *(const f32x4*)(bias + bcol0 + bj * HALF + 4 * n) : (f32x4){0.f, 0.f, 0.f, 0.f};
#pragma unroll
        for (int ai = 0; ai < 2; ++ai)
#pragma unroll
            for (int m = 0; m < 4; ++m) { bf16_t* rowp = base + (size_t)(row0 + ai * HALF + m * 16) * ldc + col0;
#pragma unroll
                for (int bj = 0; bj < 2; ++bj) { f32x4 v0 = acc[ai][bj][m][0] + bv[bj][0], v1 = acc[ai][bj][m][1] + bv[bj][1];
                    if (ACT == 1) { f32x2 a = gelu_pk((f32x2){v0[0], v0[1]}), b = gelu_pk((f32x2){v0[2], v0[3]}), c = gelu_pk((f32x2){v1[0], v1[1]}), d = gelu_pk((f32x2){v1[2], v1[3]});
                        v0 = (f32x4){a.x, a.y, b.x, b.y}; v1 = (f32x4){c.x, c.y, d.x, d.y}; }
                    v0 = v0 * sc; v1 = v1 * sc; u32x4 w; w.x = cvt_pk_bf16(v0[0], v0[1]); w.y = cvt_pk_bf16(v0[2], v0[3]); w.z = cvt_pk_bf16(v1[0], v1[1]); w.w = cvt_pk_bf16(v1[2], v1[3]);
                    *(u32x4*)(rowp + bj * HALF) = w; } }
    }
};
typedef _Float16 f16x8 __attribute__((ext_vector_type(8)));
__device__ __forceinline__ unsigned cvt_pk_f16(float lo, float hi) { unsigned r; asm volatile("v_cvt_pk_f16_f32 %0, %1, %2" : "=v"(r) : "v"(lo), "v"(hi)); return r; }
struct EpiLora {
    static constexpr bool PERM = true, AFTER_DRAIN = false;
    _Float16* T16; size_t tstride; _Float16* G;
    __device__ __forceinline__ void operator()(const f32x4 (&acc)[2][2][4][2], const Unit& u, int wr, int wc, int fr, int fq) const {
        const int tt = u.pn >> 1, colt = (u.pn & 1) * 256;
        const int row0 = u.pm * BM + wr * 64 + fr, col0 = colt + wc * 32 + 8 * fq;
        _Float16* base = (tt < 4) ? T16 + (size_t)tt * tstride : G;
#pragma unroll
        for (int ai = 0; ai < 2; ++ai)
#pragma unroll
            for (int m = 0; m < 4; ++m) { _Float16* rowp = base + (size_t)(row0 + ai * HALF + m * 16) * 512 + col0;
#pragma unroll
                for (int bj = 0; bj < 2; ++bj) {
                    const f32x4 v0 = acc[ai][bj][m][0], v1 = acc[ai][bj][m][1];
                    u32x4 w; w.x = cvt_pk_f16(v0[0], v0[1]); w.y = cvt_pk_f16(v0[2], v0[3]); w.z = cvt_pk_f16(v1[0], v1[1]); w.w = cvt_pk_f16(v1[2], v1[3]);
                    *(u32x4*)(rowp + bj * HALF) = w;
                }
            }
    }
};
template <bool BF_SSQ> struct EpiRes {
    static constexpr bool PERM = true, AFTER_DRAIN = false;
    const float* baseP; const float* baseS; float* out; bf16_t* xb; float* ssq;
    __device__ __forceinline__ void operator()(const f32x4 (&acc)[2][2][4][2], const Unit& u, int wr, int wc, int fr, int fq) const {
        const int row0 = u.pm * BM + wr * 64 + fr, col0 = u.pn * BM + wc * 32 + 8 * fq;
        const float* base = (u.pm < 256) ? baseP : baseS - (size_t)65536 * 1024;
#pragma unroll
        for (int ai = 0; ai < 2; ++ai)
#pragma unroll
            for (int m = 0; m < 4; ++m) {
                const int row = row0 + ai * HALF + m * 16; const size_t off = (size_t)row * 1024 + col0; float s = 0.f;
#pragma unroll
                for (int bj = 0; bj < 2; ++bj) {
                    const f32x4 x0 = *(const f32x4*)(base + off + bj * HALF), x1 = *(const f32x4*)(base + off + bj * HALF + 4);
                    const f32x4 v0 = acc[ai][bj][m][0] + x0, v1 = acc[ai][bj][m][1] + x1;
                    *(f32x4*)(out + off + bj * HALF) = v0; *(f32x4*)(out + off + bj * HALF + 4) = v1;
                    if (BF_SSQ) {
                        s += (v0[0] * v0[0] + v0[1] * v0[1]) + (v0[2] * v0[2] + v0[3] * v0[3]) + (v1[0] * v1[0] + v1[1] * v1[1]) + (v1[2] * v1[2] + v1[3] * v1[3]);
                        u32x4 w; w.x = cvt_pk_bf16(v0[0], v0[1]); w.y = cvt_pk_bf16(v0[2], v0[3]); w.z = cvt_pk_bf16(v1[0], v1[1]); w.w = cvt_pk_bf16(v1[2], v1[3]);
                        *(u32x4*)(xb + off + bj * HALF) = w;
                    }
                }
                if (BF_SSQ) { s += __shfl_xor(s, 16); s += __shfl_xor(s, 32); if (fq == 0) atomicAdd(ssq + row, s); }
            }
    }
};
struct EpiSwiGLU {
    static constexpr bool PERM = true, AFTER_DRAIN = false;
    bf16_t* act; const float* ssq;
    __device__ __forceinline__ void operator()(const f32x4 (&acc)[2][2][4][2], const Unit& u, int wr, int wc, int fr, int fq) const {
        const int row0 = u.pm * BM + wr * 64 + fr, col0 = u.pn * HALF + wc * 32 + 8 * fq;
#pragma unroll
        for (int ai = 0; ai < 2; ++ai)
#pragma unroll
            for (int m = 0; m < 4; ++m) {
                const int row = row0 + ai * HALF + m * 16;
                const float rstd = __builtin_amdgcn_rsqf(ssq[row] * (1.0f / 1024.0f) + 1e-6f), nrl = rstd * -1.4426950408889634f;
                f32x4 o[2];
#pragma unroll
                for (int n = 0; n < 2; ++n) {
                    const f32x4 g = acc[ai][0][m][n], up = acc[ai][1][m][n];
                    const f32x4 x = g * nrl; f32x4 d;
#pragma unroll
                    for (int i = 0; i < 4; ++i) d[i] = __builtin_amdgcn_exp2f(x[i]);
                    d = d + 1.0f;
#pragma unroll
                    for (int i = 0; i < 4; ++i) d[i] = __builtin_amdgcn_rcpf(d[i]);
                    o[n] = (g * up) * (d * (rstd * rstd));
                }
                u32x4 w; w.x = cvt_pk_bf16(o[0][0], o[0][1]); w.y = cvt_pk_bf16(o[0][2], o[0][3]); w.z = cvt_pk_bf16(o[1][0], o[1][1]); w.w = cvt_pk_bf16(o[1][2], o[1][3]);
                *(u32x4*)(act + (size_t)row * 2816 + col0) = w;
            }
    }
};

template <class Epi, class Sched, bool ALIGN_EPI = false, bool SP2 = false>
__device__ __forceinline__ void gemm_phase(PG8_LAS unsigned char* lds, const Gemm g, const Sched& S, const Epi& E) {
    const int tid = threadIdx.x, wid = __builtin_amdgcn_readfirstlane(tid >> 6), lane = tid & 63, wr = wid >> 2, wc = wid & 3, fr = lane & 15, fq = lane >> 4;
    const int K = g.K, nt = K / BK, lda = g.lda, acs = g.acs;
    unsigned voffA[2], voffB[2];
#pragma unroll
    for (int i = 0; i < 2; ++i) { int R, C; stage_rc(tid * 16 + i * 8192, R, C); const int Rb = Epi::PERM ? ((R & ~31) + perm32(R & 31)) : R;
        voffA[i] = (unsigned)(R * lda + C) * 2u; voffB[i] = (unsigned)(Rb * K + C) * 2u; }
    const size_t kstep = (size_t)(BK * 2);
    const size_t hstep = (size_t)HALF * K * 2, hstepA = (size_t)HALF * lda * 2;
    const size_t tstep = 2 * hstep, tstepA = 2 * hstepA;
#define PG8_ACOL(pn) ((size_t)(((pn) >> 2) < 2 ? ((pn) >> 2) : 2) * (size_t)acs * 2)
    const unsigned ldsw = (unsigned)wid * 1024u;
    const int aoff = lds_byte(wr * 64 + fr, fq * 8), boff = lds_byte(wc * 32 + fr, fq * 8);
#define PG8_SA(b, h) (((b) * 2 + (h)) * HTB)
#define PG8_SB(b, h) ((4 + (b) * 2 + (h)) * HTB)
#define PG8_STAGE(bufoff, gbase, voff) do { _Pragma("unroll") for (int _i = 0; _i < 2; ++_i) \
        __builtin_amdgcn_global_load_lds((const unsigned*)((const char*)(gbase) + (voff)[_i]), (PG8_LAS unsigned*)(lds + (bufoff) + ldsw + _i * 8192), 16, 0, 0); } while (0)
#define PG8_LDA(dst, b, h) do { _Pragma("unroll") for (int m = 0; m < 4; ++m) _Pragma("unroll") for (int k = 0; k < 2; ++k) dst[m][k] = *(const PG8_LAS bf16x8*)(lds + PG8_SA(b, h) + aoff + m * 2048 + k * 1024); } while (0)
#define PG8_LDB(dst, b, h) do { _Pragma("unroll") for (int n = 0; n < 2; ++n) _Pragma("unroll") for (int k = 0; k < 2; ++k) dst[n][k] = *(const PG8_LAS bf16x8*)(lds + PG8_SB(b, h) + boff + n * 2048 + k * 1024); } while (0)
#define PG8_MMA(ai, bj, At, Bt) do { __builtin_amdgcn_s_setprio(1); _Pragma("unroll") for (int m = 0; m < 4; ++m) _Pragma("unroll") for (int n = 0; n < 2; ++n) _Pragma("unroll") for (int k = 0; k < 2; ++k) \
        acc[ai][bj][m][n] = __builtin_amdgcn_mfma_f32_16x16x32_bf16(Bt[n][k], At[m][k], acc[ai][bj][m][n], 0, 0, 0); __builtin_amdgcn_s_setprio(0); } while (0)
#define PG8_WAIT_V(n) asm volatile("s_waitcnt vmcnt(" #n ")" ::: "memory")
#define PG8_WAIT_L(n) asm volatile("s_waitcnt lgkmcnt(" #n ")" ::: "memory")
#define PG8_BAR __builtin_amdgcn_s_barrier()
#define PG8_SCHED __builtin_amdgcn_sched_barrier(0)
    Unit cur, nxt; int ui = 0;
    if (!S.next(0, cur)) return;
    f32x4 acc[2][2][4][2];
#pragma unroll
    for (int a = 0; a < 2; ++a)
#pragma unroll
        for (int b = 0; b < 2; ++b)
#pragma unroll
            for (int m = 0; m < 4; ++m)
#pragma unroll
                for (int n = 0; n < 2; ++n) acc[a][b][m][n] = (f32x4){0.f, 0.f, 0.f, 0.f};
    bf16x8 At[4][2], B0[2][2], B1[2][2];
    const char* cA = (const char*)g.A + (size_t)cur.pm * tstepA + PG8_ACOL(cur.pn); const char* cB = (const char*)g.Bt + (size_t)cur.pn * tstep;
    S.a_ready(cur);
    if constexpr (SP2) {
        PG8_STAGE(PG8_SB(0, 0), cB, voffB); PG8_STAGE(PG8_SB(0, 1), cB + hstep, voffB); PG8_STAGE(PG8_SA(0, 0), cA, voffA); PG8_STAGE(PG8_SA(0, 1), cA + hstepA, voffA);
        if (wr == 1) PG8_BAR;
        PG8_WAIT_V(2); PG8_BAR;
        PG8_STAGE(PG8_SB(1, 0), cB + kstep, voffB); PG8_STAGE(PG8_SA(1, 0), cA + kstep, voffA); PG8_STAGE(PG8_SB(1, 1), cB + hstep + kstep, voffB);
        PG8_WAIT_V(6); PG8_BAR;
    } else {
        PG8_STAGE(PG8_SB(0, 0), cB, voffB); PG8_STAGE(PG8_SA(0, 0), cA, voffA); PG8_STAGE(PG8_SB(0, 1), cB + hstep, voffB); PG8_STAGE(PG8_SA(0, 1), cA + hstepA, voffA);
        if (wr == 1) PG8_BAR;
        PG8_WAIT_V(4); PG8_BAR;
        PG8_STAGE(PG8_SB(1, 0), cB + kstep, voffB); PG8_STAGE(PG8_SA(1, 0), cA + kstep, voffA); PG8_STAGE(PG8_SB(1, 1), cB + hstep + kstep, voffB);
        PG8_WAIT_V(6); PG8_BAR;
    }
    for (;;) {
        const bool has_next = S.next(ui + 1, nxt);
        const char* nA = has_next ? (const char*)g.A + (size_t)nxt.pm * tstepA + PG8_ACOL(nxt.pn) : cA; const char* nB = has_next ? (const char*)g.Bt + (size_t)nxt.pn * tstep : cB;
#pragma nounroll
        for (int t = 0; t < nt; t += 2) {
            const bool last = (t == nt - 2);
            const char* a1 = cA + (size_t)(t + 1) * kstep;
            const char* a2 = last ? nA : cA + (size_t)(t + 2) * kstep; const char* b2 = last ? nB : cB + (size_t)(t + 2) * kstep;
            const char* a3 = a2 + kstep; const char* b3 = b2 + kstep;
            if (last && has_next) S.a_ready(nxt);
            if constexpr (SP2) {
            PG8_LDB(B0, 0, 0); PG8_LDB(B1, 0, 1); PG8_SCHED; PG8_LDA(At, 0, 0); PG8_STAGE(PG8_SA(1, 1), a1 + hstepA, voffA);
            PG8_WAIT_V(8); PG8_WAIT_L(0); PG8_BAR; PG8_MMA(0, 0, At, B0); PG8_MMA(0, 1, At, B1); PG8_BAR; PG8_SCHED;
            PG8_LDA(At, 0, 1); PG8_STAGE(PG8_SB(0, 0), b2, voffB); PG8_STAGE(PG8_SB(0, 1), b2 + hstep, voffB); PG8_STAGE(PG8_SA(0, 0), a2, voffA);
            PG8_WAIT_V(8); PG8_WAIT_L(0); PG8_BAR; PG8_MMA(1, 0, At, B0); PG8_MMA(1, 1, At, B1); PG8_BAR; PG8_SCHED;
            PG8_LDB(B0, 1, 0); PG8_LDB(B1, 1, 1); PG8_SCHED; PG8_LDA(At, 1, 0); PG8_STAGE(PG8_SA(0, 1), a2 + hstepA, voffA);
            PG8_WAIT_V(8); PG8_WAIT_L(0); PG8_BAR; PG8_MMA(0, 0, At, B0); PG8_MMA(0, 1, At, B1); PG8_BAR; PG8_SCHED;
            PG8_LDA(At, 1, 1); PG8_STAGE(PG8_SB(1, 0), b3, voffB); PG8_STAGE(PG8_SB(1, 1), b3 + hstep, voffB); PG8_STAGE(PG8_SA(1, 0), a3, voffA);
            PG8_WAIT_V(8); PG8_WAIT_L(0); PG8_BAR; PG8_MMA(1, 0, At, B0); PG8_MMA(1, 1, At, B1); PG8_BAR; PG8_SCHED;
            } else {
            PG8_LDB(B0, 0, 0); PG8_SCHED; PG8_LDA(At, 0, 0); PG8_STAGE(PG8_SA(1, 1), a1 + hstepA, voffA);
            PG8_WAIT_L(8); PG8_BAR; PG8_WAIT_L(0); PG8_MMA(0, 0, At, B0); PG8_BAR; PG8_SCHED;
            PG8_LDB(B1, 0, 1); PG8_STAGE(PG8_SB(0, 0), b2, voffB);
            PG8_BAR; PG8_WAIT_L(0); PG8_MMA(0, 1, At, B1); PG8_BAR;
            PG8_LDA(At, 0, 1); PG8_STAGE(PG8_SA(0, 0), a2, voffA);
            PG8_BAR; PG8_WAIT_L(0); PG8_MMA(1, 0, At, B0); PG8_BAR; PG8_SCHED;
            PG8_STAGE(PG8_SB(0, 1), b2 + hstep, voffB);
            PG8_WAIT_V(6); PG8_BAR; PG8_MMA(1, 1, At, B1); PG8_BAR;
            PG8_LDB(B0, 1, 0); PG8_SCHED; PG8_LDA(At, 1, 0); PG8_STAGE(PG8_SA(0, 1), a2 + hstepA, voffA);
            PG8_WAIT_L(8); PG8_BAR; PG8_WAIT_L(0); PG8_MMA(0, 0, At, B0); PG8_BAR; PG8_SCHED;
            PG8_LDB(B1, 1, 1); PG8_STAGE(PG8_SB(1, 0), b3, voffB);
            PG8_BAR; PG8_WAIT_L(0); PG8_MMA(0, 1, At, B1); PG8_BAR;
            PG8_LDA(At, 1, 1); PG8_STAGE(PG8_SA(1, 0), a3, voffA);
            PG8_BAR; PG8_WAIT_L(0); PG8_MMA(1, 0, At, B0); PG8_BAR; PG8_SCHED;
            PG8_STAGE(PG8_SB(1, 1), b3 + hstep, voffB);
            PG8_WAIT_V(6); PG8_BAR; PG8_MMA(1, 1, At, B1); PG8_BAR;
            }
        }
        if constexpr (ALIGN_EPI) { if (wr == 0) PG8_BAR; }
        if constexpr (!Epi::AFTER_DRAIN) { E(acc, cur, wr, wc, fr, fq); S.done(cur); }
        if (!has_next) break;
#pragma unroll
        for (int a = 0; a < 2; ++a)
#pragma unroll
            for (int b = 0; b < 2; ++b)
#pragma unroll
                for (int m = 0; m < 4; ++m)
#pragma unroll
                    for (int n = 0; n < 2; ++n) acc[a][b][m][n] = (f32x4){0.f, 0.f, 0.f, 0.f};
        cur = nxt; cA = nA; cB = nB; ++ui;
        if constexpr (ALIGN_EPI) { if (wr == 1) PG8_BAR; }
    }
    PG8_WAIT_V(0);
    if constexpr (!ALIGN_EPI) { if (wr == 0) PG8_BAR; }
    PG8_BAR;
    if constexpr (Epi::AFTER_DRAIN) { E.fused(acc, cur, wr, wc, fr, fq, lds, wid, lane); S.done(cur); }
#undef PG8_SA
#undef PG8_SB
#undef PG8_STAGE
#undef PG8_LDA
#undef PG8_LDB
#undef PG8_MMA
#undef PG8_WAIT_V
#undef PG8_WAIT_L
#undef PG8_BAR
#undef PG8_SCHED
#undef PG8_ACOL
}
}
#include <hip/hip_bf16.h>
#include <cmath>
namespace attn_body {
using bf16=__hip_bfloat16;
using bf16x8=__attribute__((ext_vector_type(8)))short;
using s16x4=__attribute__((ext_vector_type(4)))short;
using f32x16=__attribute__((ext_vector_type(16)))float;
using u32x4=__attribute__((ext_vector_type(4)))unsigned;
constexpr int D=64,PZ=2816,PO=1024,ZQ=1920,ZKA=2432,ZVA=2560;
constexpr int NW=8,QBLK=32,QB=QBLK*NW,KVBLK=64;
constexpr int ATTN_UNIT_ROWS=QB;
__device__ __forceinline__ int crow(int r,int hi){return (r&3)+8*(r>>2)+4*hi;}
#define SBAR() __builtin_amdgcn_sched_barrier(0)
__device__ __forceinline__ void cmask(f32x16&p0,f32x16&p1,int jb,int qrel,int hi){
  const float NEG=-INFINITY; int kb=64*jb+4*hi;
  #pragma unroll
  for(int r=0;r<16;++r){int kv=kb+(r&3)+8*(r>>2); if(kv>qrel)p0[r]=NEG; if(kv+32>qrel)p1[r]=NEG;}
}

constexpr int NSLOT=3, SLOTB=8192;
constexpr int LDS_K=0, LDS_V=NSLOT*SLOTB, LDS_WS=2*NSLOT*SLOTB, LDS_OST=LDS_WS+NW*64*4, LDS_BYTES=LDS_OST+NW*4096;
constexpr float C2=0.125f*1.4426950408889634f;
__device__ __forceinline__ void glds16(const void*gsrc,unsigned lds_dst){unsigned keep;
  asm volatile("s_mov_b32 %0, m0\n\ts_mov_b32 m0, %2\n\ts_nop 0\n\tglobal_load_lds_dwordx4 %1, off\n\ts_mov_b32 m0, %0":"=&s"(keep):"v"(gsrc),"s"(lds_dst):"memory");}
__device__ __forceinline__ float max3f(float a,float b,float c){float r;asm("v_max3_f32 %0, %1, %2, %3":"=v"(r):"v"(a),"v"(b),"v"(c));return r;}
__device__ __forceinline__ float max2f(float a,float b){float r;asm("v_max_f32_e32 %0, %1, %2":"=v"(r):"v"(a),"v"(b));return r;}
__device__ __forceinline__ float fadd_s(float a,float b){float r;asm("v_add_f32_e32 %0, %1, %2":"=v"(r):"v"(a),"v"(b));return r;}
__device__ __forceinline__ float fsub_s(float a,float b){float r;asm("v_sub_f32_e32 %0, %1, %2":"=v"(r):"v"(a),"v"(b));return r;}
typedef float f32x2_t __attribute__((ext_vector_type(2))); typedef __bf16 bf16x2_t __attribute__((ext_vector_type(2)));
__device__ __forceinline__ unsigned cvtpk_s(float lo,float hi){f32x2_t v={lo,hi};bf16x2_t b=__builtin_convertvector(v,bf16x2_t);return __builtin_bit_cast(unsigned,b);}
#define WAIT_BAR(N) asm volatile("s_waitcnt vmcnt(" #N ") lgkmcnt(0)\n\ts_barrier":::"memory")

__device__ __forceinline__ void qkt(f32x16&p0,f32x16&p1,const char*Kslot,const bf16x8*qr,const f32x16&negm,int r32,int hi){
  const char*kb=Kslot+hi*1024+r32*16;
  #pragma unroll
  for(int d0=0;d0<4;++d0){
    const bf16x8 b0=*reinterpret_cast<const bf16x8*>(kb+d0*2048);
    const bf16x8 b1=*reinterpret_cast<const bf16x8*>(kb+d0*2048+512);
    if(d0==0){p0=__builtin_amdgcn_mfma_f32_32x32x16_bf16(b0,qr[0],negm,0,0,0);p1=__builtin_amdgcn_mfma_f32_32x32x16_bf16(b1,qr[0],negm,0,0,0);}
    else{p0=__builtin_amdgcn_mfma_f32_32x32x16_bf16(b0,qr[d0],p0,0,0,0);p1=__builtin_amdgcn_mfma_f32_32x32x16_bf16(b1,qr[d0],p1,0,0,0);}}
}
typedef __attribute__((address_space(3))) const char* lds_cptr;
typedef short v4i16_t __attribute__((ext_vector_type(4)));
__device__ __forceinline__ void kload8(bf16x8*kf,lds_cptr kp){
  kf[0]=*(const __attribute__((address_space(3))) bf16x8*)(kp);      kf[1]=*(const __attribute__((address_space(3))) bf16x8*)(kp+512);
  kf[2]=*(const __attribute__((address_space(3))) bf16x8*)(kp+2048); kf[3]=*(const __attribute__((address_space(3))) bf16x8*)(kp+2560);
  kf[4]=*(const __attribute__((address_space(3))) bf16x8*)(kp+4096); kf[5]=*(const __attribute__((address_space(3))) bf16x8*)(kp+4608);
  kf[6]=*(const __attribute__((address_space(3))) bf16x8*)(kp+6144); kf[7]=*(const __attribute__((address_space(3))) bf16x8*)(kp+6656);
}
__device__ __forceinline__ void kload2(bf16x8*kf,lds_cptr kp,int j){ kf[2*j]=*(const __attribute__((address_space(3))) bf16x8*)(kp+j*2048); kf[2*j+1]=*(const __attribute__((address_space(3))) bf16x8*)(kp+j*2048+512); }
__device__ __forceinline__ s16x4 vtr(lds_cptr p){ return __builtin_bit_cast(s16x4,__builtin_amdgcn_ds_read_tr16_b64_v4i16((__attribute__((address_space(3))) v4i16_t*)p)); }
__device__ __forceinline__ float rowmax(const f32x16&p0,const f32x16&p1){
  float a=max3f(p0[0],p0[1],p1[0]),b=max3f(p0[2],p0[3],p1[1]);a=max3f(a,p1[2],p1[3]);
  #pragma unroll
  for(int r=4;r<16;r+=4){a=max3f(a,p0[r],p0[r+1]);b=max3f(b,p0[r+2],p0[r+3]);a=max3f(a,p1[r],p1[r+1]);b=max3f(b,p1[r+2],p1[r+3]);}
  const float m=max2f(a,b);
  auto rr=__builtin_amdgcn_permlane32_swap(__float_as_uint(m),__float_as_uint(m),false,false);
  return max2f(__uint_as_float(rr[0]),__uint_as_float(rr[1]));
}
__device__ __forceinline__ void pv(f32x16*o,int vb,bf16x8 pa0,bf16x8 pa1,bf16x8 pa2,bf16x8 pa3){
  #pragma unroll
  for(int d0=0;d0<2;++d0){s16x4 lo[4],hi[4];
    #pragma unroll
    for(int ks=0;ks<4;++ks){
      asm volatile("ds_read_b64_tr_b16 %0,%1 offset:%c2":"=&v"(lo[ks]):"v"(vb),"i"(d0*4096+ks*1024):"memory");
      asm volatile("ds_read_b64_tr_b16 %0,%1 offset:%c2":"=&v"(hi[ks]):"v"(vb),"i"(d0*4096+ks*1024+512):"memory");}
    asm volatile("s_waitcnt lgkmcnt(0)":::"memory");SBAR();
    #define PK(k) (bf16x8){lo[k][0],lo[k][1],lo[k][2],lo[k][3],hi[k][0],hi[k][1],hi[k][2],hi[k][3]}
    o[d0]=__builtin_amdgcn_mfma_f32_32x32x16_bf16(pa0,PK(0),o[d0],0,0,0);
    o[d0]=__builtin_amdgcn_mfma_f32_32x32x16_bf16(pa1,PK(1),o[d0],0,0,0);
    o[d0]=__builtin_amdgcn_mfma_f32_32x32x16_bf16(pa2,PK(2),o[d0],0,0,0);
    o[d0]=__builtin_amdgcn_mfma_f32_32x32x16_bf16(pa3,PK(3),o[d0],0,0,0);
    #undef PK
  }
}

#ifndef ATTN_STORE16
#define ATTN_STORE16(p,v) (*(u32x4*)(p)=(v))
#endif
template<int THRL> __device__ __forceinline__ void attn_unit(long rowbase,int T,int h,int qb,const bf16*Z,bf16*O,char*shm){
  int tid_=threadIdx.x; asm volatile("":"+v"(tid_));
  const int tid=tid_,lane=tid&63,r32=lane&31,hi=lane>>5; const int wid=__builtin_amdgcn_readfirstlane(tid>>6);
  const int q0=qb*QB;
  const bf16*Qw=Z+(rowbase+q0+wid*QBLK)*PZ+ZQ+h*D;
  const bf16*Kh=Z+rowbase*PZ+ZKA+(h>>2)*D,*Vh=Z+rowbase*PZ+ZVA+(h>>2)*D;
  const unsigned lds0=(unsigned)(uintptr_t)shm;
  float*wsf=(float*)(shm+LDS_WS)+wid*64;
  const bf16*ksrc=Kh+(long)lane*PZ+wid*8;
  const bf16*vsrc=Vh+(long)(16*(wid&3)+(lane>>2))*PZ+(wid>>2)*32+(lane&3)*8;
  const unsigned kdst=lds0+LDS_K+wid*1024, vdst=lds0+LDS_V+wid*1024;
  #define DMA_K(t,slot) glds16(ksrc+(long)(t)*KVBLK*PZ,(unsigned)__builtin_amdgcn_readfirstlane(kdst+(slot)))
  #define DMA_V(t,slot) glds16(vsrc+(long)(t)*KVBLK*PZ,(unsigned)__builtin_amdgcn_readfirstlane(vdst+(slot)))
  const int vb0=(int)(lds0+LDS_V)+((lane>>4)&1)*32+(lane&3)*8+(4*hi+((lane&15)>>2))*64;
  const char*Kbase=shm+LDS_K; bf16x8 kf[8];
  const lds_cptr shm3=(lds_cptr)shm; const lds_cptr kp0=shm3+LDS_K+hi*1024+r32*16; const lds_cptr vp0=shm3+LDS_V+((lane>>4)&1)*32+(lane&3)*8+(4*hi+((lane&15)>>2))*64;
  const int NT=T/KVBLK;
  DMA_K(0,0);DMA_V(0,0);DMA_K(1,SLOTB);
  bf16x8 qr[4];
  #pragma unroll
  for(int d0=0;d0<4;++d0)qr[d0]=*reinterpret_cast<const bf16x8*>(&Qw[(long)r32*PZ+d0*16+hi*8]);
  float mhat=0.f,l_reg=0.f;f32x16 o[2];o[0]=f32x16{};o[1]=f32x16{};f32x16 negm=f32x16{};asm volatile("":"+v"(negm));
  const int qrel=wid*QBLK+r32;
  #define CMASK(P0,P1,t) do{}while(0)
  bool resc=false;
  #define START(P0,P1) do{ const float rm=rowmax(P0,P1); resc=false; \
    { const float dl=rm; mhat=fadd_s(mhat,dl); \
      _Pragma("unroll") for(int r=0;r<16;++r){P0[r]=fsub_s(P0[r],dl);P1[r]=fsub_s(P1[r],dl);} \
      _Pragma("unroll") for(int r=0;r<16;++r)negm[r]=-mhat; asm volatile("":"+v"(negm)); } \
    _Pragma("unroll") for(int r=0;r<16;++r)P0[r]=__builtin_amdgcn_exp2f(P0[r]); }while(0)
  #define RESC() do{ if(resc){ asm volatile("s_waitcnt lgkmcnt(0)":::"memory"); \
      _Pragma("unroll") for(int d_=0;d_<2;++d_) _Pragma("unroll") for(int r=0;r<16;++r)o[d_][r]*=wsf[crow(r,hi)]; } }while(0)
  f32x16 pA0,pA1,pB0,pB1;
  int sl_prev=0,sl_cur=0,sl_next=SLOTB;
  #define ROT() do{sl_prev=sl_cur;sl_cur=sl_next;sl_next=(sl_next==(NSLOT-1)*SLOTB)?0:sl_next+SLOTB;}while(0)
  DMA_K(2,2*SLOTB);
  WAIT_BAR(3);
  qkt(pA0,pA1,Kbase,qr,negm,r32,hi);asm volatile("s_nop 15\n\ts_nop 7":"+v"(pA0),"+v"(pA1));CMASK(pA0,pA1,0);
  START(pA0,pA1);
  _Pragma("unroll") for(int r=0;r<16;++r)pA1[r]=__builtin_amdgcn_exp2f(pA1[r]);
  WAIT_BAR(0);
  DMA_K(3,0);DMA_V(1,SLOTB);
  ROT();
  kload8(kf,kp0+sl_cur);
  WAIT_BAR(2);
  s16x4 vlo[8],vhi[8]; u32x4 pw0,pw1,pw2,pw3;
  #define PKW(P,B) cvtpk_s(P[B],P[B+1])
  #define PAF(k) __builtin_bit_cast(bf16x8,pw##k)
  #define VFR(i) (bf16x8){vlo[i][0],vlo[i][1],vlo[i][2],vlo[i][3],vhi[i][0],vhi[i][1],vhi[i][2],vhi[i][3]}
  #define PIN(x) asm volatile("":"+v"(x))
  #define MX3(a,b,c) __builtin_fmaxf(__builtin_fmaxf((a),(b)),(c))
  #define GAPA(MF,A0,A1,A2,A3,W0,W1,PW) do{ MF; sacc+=A0; sacc+=A1; sacc+=A2; sacc+=A3; PIN(sacc); W0; W1; PIN(PW); SBAR(); }while(0)
  #define EX(v) __builtin_amdgcn_exp2f(v)
  #define GAPB(MF,X,B) do{ MF; X[B]=EX(X[B]); X[B+1]=EX(X[B+1]); X[B+2]=EX(X[B+2]); X[B+3]=EX(X[B+3]); PIN(X); SBAR(); }while(0)
  #define VRD(i) do{ vlo[i]=vtr(vp_+(((i)>>2)*4096+((i)&3)*1024)); vhi[i]=vtr(vp_+(((i)>>2)*4096+((i)&3)*1024+512)); }while(0)
  #define KRD(G,j) do{ if(G){ kload2(kf,kp0+sl_next,j); SBAR(); } }while(0)
  #define STEP(C0,C1,P0,P1,t,GK,GV,GL) do{ SBAR(); \
    const lds_cptr vp_=vp0+sl_prev; \
    VRD(0); SBAR(); float sacc=(P0[0]+P0[1]); \
    GAPA(C0=__builtin_amdgcn_mfma_f32_32x32x16_bf16(kf[0],qr[0],negm,0,0,0), P0[2],P0[3],P0[4],P0[5],     pw0[0]=PKW(P0,0), pw0[1]=PKW(P0,2), pw0); \
    VRD(4); SBAR(); GAPA(C1=__builtin_amdgcn_mfma_f32_32x32x16_bf16(kf[1],qr[0],negm,0,0,0), P0[6],P0[7],P0[8],P0[9],     pw0[2]=PKW(P0,4), pw0[3]=PKW(P0,6), pw0); \
    VRD(1); SBAR(); GAPA(C0=__builtin_amdgcn_mfma_f32_32x32x16_bf16(kf[2],qr[1],C0,0,0,0),   P0[10],P0[11],P0[12],P0[13], pw1[0]=PKW(P0,8), pw1[1]=PKW(P0,10), pw1); \
    VRD(5); SBAR(); GAPA(C1=__builtin_amdgcn_mfma_f32_32x32x16_bf16(kf[3],qr[1],C1,0,0,0),   P0[14],P0[15],P1[0],P1[1],   pw1[2]=PKW(P0,12),pw1[3]=PKW(P0,14), pw1); \
    VRD(2); SBAR(); GAPA(C0=__builtin_amdgcn_mfma_f32_32x32x16_bf16(kf[4],qr[2],C0,0,0,0),   P1[2],P1[3],P1[4],P1[5],     pw2[0]=PKW(P1,0), pw2[1]=PKW(P1,2), pw2); \
    VRD(6); SBAR(); GAPA(C1=__builtin_amdgcn_mfma_f32_32x32x16_bf16(kf[5],qr[2],C1,0,0,0),   P1[6],P1[7],P1[8],P1[9],     pw2[2]=PKW(P1,4), pw2[3]=PKW(P1,6), pw2); \
    VRD(3); SBAR(); GAPA(C0=__builtin_amdgcn_mfma_f32_32x32x16_bf16(kf[6],qr[3],C0,0,0,0),   P1[10],P1[11],P1[12],P1[13], pw3[0]=PKW(P1,8), pw3[1]=PKW(P1,10), pw3); \
    VRD(7); SBAR(); GAPA(C1=__builtin_amdgcn_mfma_f32_32x32x16_bf16(kf[7],qr[3],C1,0,0,0),   P1[14],P1[15],0.f,0.f,       pw3[2]=PKW(P1,12),pw3[3]=PKW(P1,14), pw3); \
    l_reg+=sacc; \
    if(GK){DMA_K((t)+3,sl_cur);} if(GV){DMA_V((t)+1,sl_next);} \
    CMASK(C0,C1,t); \
    { float a=MX3(C0[0],C0[1],C1[0]),b=MX3(C0[2],C0[3],C1[1]); a=MX3(a,C1[2],C1[3]); \
      _Pragma("unroll") for(int r=4;r<16;r+=4){a=MX3(a,C0[r],C0[r+1]);b=MX3(b,C0[r+2],C0[r+3]);a=MX3(a,C1[r],C1[r+1]);b=MX3(b,C1[r+2],C1[r+3]);} \
      float rm=__builtin_fmaxf(a,b); { auto rr=__builtin_amdgcn_permlane32_swap(__float_as_uint(rm),__float_as_uint(rm),false,false); rm=__builtin_fmaxf(__uint_as_float(rr[0]),__uint_as_float(rr[1])); } \
      resc=false; \
      if(__builtin_expect(__any(rm>(float)THRL),0)){ const float dl=__builtin_fmaxf(rm,0.f); mhat+=dl; \
        _Pragma("unroll") for(int r=0;r<16;++r){C0[r]-=dl;C1[r]-=dl;} \
        _Pragma("unroll") for(int r=0;r<16;++r)negm[r]=-mhat; asm volatile("":"+v"(negm)); \
        const float f=__builtin_amdgcn_exp2f(-dl); l_reg*=f; if(hi==0)wsf[r32]=f; resc=true; } } \
    SBAR(); \
    GAPB(o[0]=__builtin_amdgcn_mfma_f32_32x32x16_bf16(PAF(0),VFR(0),o[0],0,0,0), C0,0); \
    GAPB(o[1]=__builtin_amdgcn_mfma_f32_32x32x16_bf16(PAF(0),VFR(4),o[1],0,0,0), C0,4); \
    KRD(GL,0); GAPB(o[0]=__builtin_amdgcn_mfma_f32_32x32x16_bf16(PAF(1),VFR(1),o[0],0,0,0), C0,8); \
    KRD(GL,1); GAPB(o[1]=__builtin_amdgcn_mfma_f32_32x32x16_bf16(PAF(1),VFR(5),o[1],0,0,0), C0,12); \
    KRD(GL,2); GAPB(o[0]=__builtin_amdgcn_mfma_f32_32x32x16_bf16(PAF(2),VFR(2),o[0],0,0,0), C1,0); \
    KRD(GL,3); GAPB(o[1]=__builtin_amdgcn_mfma_f32_32x32x16_bf16(PAF(2),VFR(6),o[1],0,0,0), C1,4); \
    GAPB(o[0]=__builtin_amdgcn_mfma_f32_32x32x16_bf16(PAF(3),VFR(3),o[0],0,0,0), C1,8); \
    GAPB(o[1]=__builtin_amdgcn_mfma_f32_32x32x16_bf16(PAF(3),VFR(7),o[1],0,0,0), C1,12); \
    }while(0)
  int t=1;
  #undef CMASK
  #define CMASK(P0,P1,t) do{}while(0)
  for(;t+5<NT;t+=2){
    STEP(pB0,pB1,pA0,pA1,t,true,true,true);     WAIT_BAR(2); RESC(); ROT();
    STEP(pA0,pA1,pB0,pB1,t+1,true,true,true);   WAIT_BAR(2); RESC(); ROT();
  }
  #undef CMASK
  #define CMASK(P0,P1,t) do{}while(0)
  #define ENDW(tt) do{ if((tt)+3<NT){WAIT_BAR(2);} else if((tt)+2<NT){WAIT_BAR(1);} else {WAIT_BAR(0);} }while(0)
  for(;t+1<NT;t+=2){
    STEP(pB0,pB1,pA0,pA1,t,(t+3<NT),(t+1<NT),(t+1<NT));       ENDW(t);   RESC(); ROT();
    STEP(pA0,pA1,pB0,pB1,t+1,(t+4<NT),(t+2<NT),(t+2<NT));     ENDW(t+1); RESC(); ROT();
  }
  STEP(pB0,pB1,pA0,pA1,NT-1,false,false,false); RESC();
  { float sacc=pB0[0]+pB0[1]; _Pragma("unroll") for(int r=2;r<16;++r)sacc+=pB0[r]; _Pragma("unroll") for(int r=0;r<16;++r)sacc+=pB1[r]; l_reg+=sacc;
    pw0=(u32x4){PKW(pB0,0),PKW(pB0,2),PKW(pB0,4),PKW(pB0,6)};pw1=(u32x4){PKW(pB0,8),PKW(pB0,10),PKW(pB0,12),PKW(pB0,14)};pw2=(u32x4){PKW(pB1,0),PKW(pB1,2),PKW(pB1,4),PKW(pB1,6)};pw3=(u32x4){PKW(pB1,8),PKW(pB1,10),PKW(pB1,12),PKW(pB1,14)};
    SBAR(); pv(o,vb0+sl_cur,PAF(0),PAF(1),PAF(2),PAF(3)); }
  #undef PKW
  #undef PAF
  #undef VFR
  #undef PIN
  #undef MX3
  #undef GAPA
  #undef GAPB
  #undef EX
  #undef VRD
  #undef KRD
  #undef STEP
  #undef ENDW
  {auto rr=__builtin_amdgcn_permlane32_swap(__float_as_uint(l_reg),__float_as_uint(l_reg),false,false);l_reg=__uint_as_float(rr[0])+__uint_as_float(rr[1]);}
  if(hi==0)wsf[32+r32]=l_reg;asm volatile("s_waitcnt lgkmcnt(0)":::"memory");
  float rli[16];
  #pragma unroll
  for(int r=0;r<16;++r)rli[r]=__builtin_amdgcn_rcpf(wsf[32+crow(r,hi)]);
  bf16*Ow=O+(rowbase+q0+wid*QBLK)*PO+512+h*D;
  { bf16*stg=(bf16*)(shm+LDS_OST)+wid*2048;
    #pragma unroll
    for(int r=0;r<16;++r){const int orow=crow(r,hi);
      #pragma unroll
      for(int d0=0;d0<2;++d0)stg[orow*64+d0*32+r32]=__float2bfloat16(o[d0][r]*rli[r]);}
    asm volatile("s_waitcnt lgkmcnt(0)":::"memory");
    #pragma unroll
    for(int i=0;i<4;++i){const int row=i*8+(lane>>3),ch=lane&7; const u32x4 v=*(const u32x4*)(stg+row*64+ch*8); ATTN_STORE16(Ow+(long)row*PO+ch*8,v);} }
  asm volatile("s_waitcnt lgkmcnt(0)\n\ts_barrier":::"memory");
  #undef DMA_K
  #undef DMA_V
  #undef CMASK
  #undef START
  #undef RESC
  #undef ROT
}
constexpr int ATTN_LDS_BYTES=LDS_BYTES;
#undef SBAR
#undef WAIT_BAR
}
namespace cg = cooperative_groups;
#define LAS __attribute__((address_space(3)))
typedef unsigned short bf16;
typedef float f32x4 __attribute__((ext_vector_type(4)));
typedef float f32x2 __attribute__((ext_vector_type(2)));
typedef unsigned v4u __attribute__((ext_vector_type(4)));
typedef _Float16 f16x4 __attribute__((ext_vector_type(4)));
constexpr int NWAVES = 8, NTHR = 512;
constexpr int DMODEL = 1024, MP = 65536, MS = 32768, MTOT = 98304, TP = 2048, TS = 16384;
constexpr int PZ = 2816, NIN = 2688, DFF = 2816, KL = 384, NL = 2560;
constexpr int ZWF = 1536, ZQ = 1920;
constexpr size_t MiB = 1u << 20;
constexpr size_t WS_CTL = 0, CTL_ZERO_BYTES = 2 * MiB;
constexpr size_t WS_SSQ = 1 * MiB;
constexpr size_t WS_BIAS = 31 * MiB;
constexpr size_t WS_WIN = 2 * MiB, WS_WOUT = 8 * MiB, WS_WGU = 10 * MiB, WS_WDN = 22 * MiB, WS_WL = 28 * MiB;
constexpr size_t WS_Z = 32 * MiB;
constexpr size_t WS_A = 560 * MiB;
constexpr size_t WS_YCAT = 752 * MiB;
constexpr size_t WS_U = 944 * MiB;
constexpr size_t WS_END = 1024 * MiB;
constexpr int CW_QUEUE = 64;
constexpr int RING_BYTES = 131072, MISC_OFF = RING_BYTES + 320, LDS_BYTES = 147456;
constexpr int NPHASE = 10;

struct Params {
    const float* in[28]; float* out; unsigned char* ws; int ph_lo, ph_hi;
};

__device__ __forceinline__ unsigned pkbf(float lo, float hi) { return pg8::cvt_pk_bf16(lo, hi); }
__device__ __forceinline__ void cvt4bf(uint2 u, float (&o)[4]) { o[0] = __uint_as_float(u.x << 16); o[1] = __uint_as_float(u.x & 0xffff0000u); o[2] = __uint_as_float(u.y << 16); o[3] = __uint_as_float(u.y & 0xffff0000u); }
__device__ __forceinline__ uint2 pack4bf(const float (&v)[4]) { uint2 u; u.x = pkbf(v[0], v[1]); u.y = pkbf(v[2], v[3]); return u; }
__device__ __forceinline__ void cvt4h(uint2 u, float (&o)[4]) { f16x4 h = __builtin_bit_cast(f16x4, u); o[0] = (float)h[0]; o[1] = (float)h[1]; o[2] = (float)h[2]; o[3] = (float)h[3]; }
__device__ __forceinline__ float wave_sum(float v) {
#pragma unroll
    for (int o = 1; o < 64; o <<= 1) v += __shfl_xor(v, o);
    return v;
}
__device__ __forceinline__ float sum16(float v) { v += __shfl_xor(v, 1); v += __shfl_xor(v, 2); v += __shfl_xor(v, 4); v += __shfl_xor(v, 8); return v; }
__device__ __forceinline__ float dpp_x1(float x) { return __int_as_float(__builtin_amdgcn_mov_dpp(__float_as_int(x), 0xB1, 0xF, 0xF, true)); }
__device__ __forceinline__ float dpp_x2(float x) { return __int_as_float(__builtin_amdgcn_mov_dpp(__float_as_int(x), 0x4E, 0xF, 0xF, true)); }
__device__ __forceinline__ float dpp_hm(float x) { return __int_as_float(__builtin_amdgcn_mov_dpp(__float_as_int(x), 0x141, 0xF, 0xF, true)); }
__device__ __forceinline__ float sigm(float x) { return 1.0f / (1.0f + __expf(-x)); }

__device__ __forceinline__ void transpose_item(const float* W, int N, int k0, int n0, bf16* WT, int ldt, int dst_row0, int dst_k0, const float* kscale, LAS float* scr, int lane) {
#pragma unroll 8
    for (int i = 0; i < 32; ++i) { const int kk = 2 * i + (lane >> 5); float v = W[(size_t)(k0 + kk) * N + n0 + (lane & 31)]; if (kscale) v *= kscale[k0 + kk]; scr[kk * 33 + (lane & 31)] = v; }
    asm volatile("s_waitcnt lgkmcnt(0)" ::: "memory");
    const int c = lane & 7;
#pragma unroll
    for (int j = 0; j < 4; ++j) { const int n = (lane >> 3) + 8 * j; const LAS float* s = scr + (8 * c) * 33 + n;
        v4u o; o.x = pkbf(s[0 * 33], s[1 * 33]); o.y = pkbf(s[2 * 33], s[3 * 33]); o.z = pkbf(s[4 * 33], s[5 * 33]); o.w = pkbf(s[6 * 33], s[7 * 33]);
        *(v4u*)(WT + (size_t)(dst_row0 + n) * ldt + dst_k0 + 8 * c) = o; }
    asm volatile("s_waitcnt lgkmcnt(0)" ::: "memory");
}

__device__ __forceinline__ void p0_prologue(const Params& p, LAS unsigned char* lds) {
    const int tid = threadIdx.x, lane = tid & 63, wave = tid >> 6;
    LAS float* scr = (LAS float*)(lds + wave * 16384);
    const int gw = blockIdx.x * NWAVES + wave, NGW = gridDim.x * NWAVES;
    bf16* Win = (bf16*)(p.ws + WS_WIN); bf16* Wout = (bf16*)(p.ws + WS_WOUT); bf16* Wgu = (bf16*)(p.ws + WS_WGU); bf16* Wdn = (bf16*)(p.ws + WS_WDN); bf16* Wl = (bf16*)(p.ws + WS_WL);
    constexpr int I_IN = 16 * (NIN / 32), I_OUT = 16 * 32, I_G = 16 * (DFF / 32), I_DN = (DFF / 64) * 32;
    constexpr int NITEMS = I_IN + I_OUT + 2 * I_G + I_DN;
    for (int it = gw; it < NITEMS; it += NGW) {
        int r = it;
        if (r < I_IN) { const int nb = r % (NIN / 32), kb = r / (NIN / 32); transpose_item(p.in[3], NIN, 64 * kb, 32 * nb, Win, 1024, 32 * nb, 64 * kb, nullptr, scr, lane); continue; } r -= I_IN;
        if (r < I_OUT) { const int nb = r % 32, kb = r / 32; transpose_item(p.in[22], 1024, 64 * kb, 32 * nb, Wout, 1024, 32 * nb, 64 * kb, nullptr, scr, lane); continue; } r -= I_OUT;
        if (r < 2 * I_G) { const int up = r >= I_G; if (up) r -= I_G; const int nb = r % (DFF / 32), kb = r / (DFF / 32), n0 = 32 * nb;
            transpose_item(up ? p.in[25] : p.in[24], DFF, 64 * kb, n0, Wgu, 1024, 256 * (n0 >> 7) + (n0 & 127) + (up ? 128 : 0), 64 * kb, p.in[23], scr, lane); continue; } r -= 2 * I_G;
        { const int nb = r % 32, kb = r / 32; transpose_item(p.in[26], 1024, 64 * kb, 32 * nb, Wdn, DFF, 32 * nb, 64 * kb, nullptr, scr, lane); }
    }
    const int gt = blockIdx.x * NTHR + tid, NGT = gridDim.x * NTHR;
    for (int i = gt; i < (int)(CTL_ZERO_BYTES / 16); i += NGT) *(v4u*)(p.ws + WS_CTL + (size_t)i * 16) = (v4u){0u, 0u, 0u, 0u};
    for (int i = gt; i < 128 * 1024 / 8; i += NGT) *(v4u*)(Win + (size_t)NIN * 1024 + (size_t)i * 8) = (v4u){0u, 0u, 0u, 0u};
    for (int i = gt; i < NL * 16; i += NGT) {
        const int n = i >> 4, c = i & 15, k = 8 * c, blk = n >> 9, nn = n & 511;
        const bool odd = (blk == 1 || blk == 3);
        v4u o = (v4u){0u, 0u, 0u, 0u};
        if (blk == 4 || (odd ? (k >= 64) : (k < 64))) {
            const int kk = (blk == 4) ? k : (odd ? k - 64 : k);
            const float* src = p.in[blk == 0 ? 10 : blk == 1 ? 12 : blk == 2 ? 14 : blk == 3 ? 16 : 17] + (size_t)kk * 512 + nn;
            o.x = pkbf(src[0], src[512]); o.y = pkbf(src[1024], src[1536]); o.z = pkbf(src[2048], src[2560]); o.w = pkbf(src[3072], src[3584]);
        }
        *(v4u*)(Wl + (size_t)n * 128 + k) = o;
    }
    bf16* XN = (bf16*)(p.ws + WS_A); const float* g1 = p.in[2];
    f32x4 gv[4];
#pragma unroll
    for (int j = 0; j < 4; ++j) gv[j] = *((const f32x4*)g1 + lane + 64 * j);
    for (int it = gw; it < MTOT / 4; it += NGW) {
        f32x4 v[4][4];
#pragma unroll
        for (int r = 0; r < 4; ++r) { const int m = 4 * it + r;
            const float* xrow = (m < MP) ? p.in[0] + (size_t)m * 1024 : p.in[1] + (size_t)(m - MP) * 1024;
            const f32x4* xr = (const f32x4*)xrow + lane;
#pragma unroll
            for (int j = 0; j < 4; ++j) v[r][j] = __builtin_nontemporal_load(xr + 64 * j); }
#pragma unroll
        for (int r = 0; r < 4; ++r) { const int m = 4 * it + r; float s = 0.f;
#pragma unroll
            for (int j = 0; j < 4; ++j) s += (v[r][j].x * v[r][j].x + v[r][j].y * v[r][j].y) + (v[r][j].z * v[r][j].z + v[r][j].w * v[r][j].w);
            const float rstd = 1.0f / sqrtf(wave_sum(s) * (1.0f / 1024.0f) + 1e-6f);
            uint2* o8 = (uint2*)(XN + (size_t)m * 1024) + lane;
#pragma unroll
            for (int j = 0; j < 4; ++j) { uint2 o; o.x = pkbf(v[r][j].x * rstd * gv[j].x, v[r][j].y * rstd * gv[j].y); o.y = pkbf(v[r][j].z * rstd * gv[j].z, v[r][j].w * rstd * gv[j].w); o8[64 * j] = o; } }
    }
}

__device__ __forceinline__ void p2_prep(const Params& p) {
    const int tid = threadIdx.x, lane = tid & 63, wave = tid >> 6;
    const int gw = blockIdx.x * NWAVES + wave, NGW = gridDim.x * NWAVES;
    bf16* Z = (bf16*)(p.ws + WS_Z); bf16* U = (bf16*)(p.ws + WS_U);
    const float* mup = p.in[4]; const float* mun = p.in[5]; const float* qg = p.in[20]; const float* kg = p.in[21];
    const int l = lane & 15, hq = lane >> 4;
    float gq[4], gk[4], inv[4];
#pragma unroll
    for (int i = 0; i < 4; ++i) { gq[i] = qg[4 * l + i]; gk[i] = kg[4 * l + i]; inv[i] = exp2f(-(float)(4 * (l & 3) + i) * (13.287712379549449f / 16.0f)); }
    float mp0[4], mn0[4], mp1[4], mn1[4];
#pragma unroll
    for (int i = 0; i < 4; ++i) { mp0[i] = mup[ZWF + 4 * lane + i]; mn0[i] = mun[ZWF + 4 * lane + i]; const int c1 = ZWF + 256 + 4 * (lane & 31) + i; mp1[i] = mup[c1]; mn1[i] = mun[c1]; }
    for (int it = gw; it < MTOT / 4; it += NGW) {
        uint2 qa[4][3], ub[4][3], uc[4][3];
#pragma unroll
        for (int r = 0; r < 4; ++r) { const int m = 4 * it + r; int t, T;
            if (m < MP) { t = m & (TP - 1); T = TP; } else { t = (m - MP) & (TS - 1); T = TS; }
            const bf16* zrow = Z + (size_t)m * PZ;
#pragma unroll
            for (int ps = 0; ps < 3; ++ps) { const int head = ps * 4 + hq, hd = head < 10 ? head : 9; qa[r][ps] = *(const uint2*)(zrow + ZQ + hd * 64 + 4 * l); }
            const bf16* zc = zrow + ZWF + 4 * lane; const bf16* zc2 = zrow + ZWF + 256 + 4 * (lane & 31);
            ub[r][1] = *(const uint2*)zc; uc[r][1] = *(const uint2*)zc2;
            ub[r][0] = (t > 0) ? *(const uint2*)(zc - PZ) : (uint2){0u, 0u}; uc[r][0] = (t > 0) ? *(const uint2*)(zc2 - PZ) : (uint2){0u, 0u};
            ub[r][2] = (t < T - 1) ? *(const uint2*)(zc + PZ) : (uint2){0u, 0u}; uc[r][2] = (t < T - 1) ? *(const uint2*)(zc2 + PZ) : (uint2){0u, 0u};
        }
#pragma unroll
        for (int r = 0; r < 4; ++r) { const int m = 4 * it + r; int t;
            if (m < MP) { t = m & (TP - 1); } else { t = (m - MP) & (TS - 1); }
            const float prow = (float)(t >> 6), pcol = (float)(t & 63);
            bf16* zrow = Z + (size_t)m * PZ;
            const float pos = (l & 8) ? pcol : prow; const bool first = !(l & 4);
            float sn[4], cs[4];
#pragma unroll
            for (int i = 0; i < 4; ++i) { const float ang = pos * inv[i]; const float nr = rintf(ang * 0.15915494309189535f);
                float rr = fmaf(-nr, 6.2831855f, ang); rr = fmaf(-nr, -1.7484555e-7f, rr); sn[i] = __sinf(rr); cs[i] = __cosf(rr); }
#pragma unroll
            for (int ps = 0; ps < 3; ++ps) {
                const int head = ps * 4 + hq; const bool act = head < 10; const int hd = act ? head : 9;
                float x[4]; cvt4bf(qa[r][ps], x);
                float ss = (x[0] * x[0] + x[1] * x[1]) + (x[2] * x[2] + x[3] * x[3]); ss = sum16(ss);
                const float rstd = 1.0f / sqrtf(ss * (1.0f / 64.0f) + 1e-6f);
                float o[4];
#pragma unroll
                for (int i = 0; i < 4; ++i) {
                    const float xn = x[i] * rstd * (hd < 8 ? gq[i] : gk[i]);
                    const float pr = __shfl_xor(xn, 4);
                    float v = first ? (xn * cs[i] - pr * sn[i]) : (xn * cs[i] + pr * sn[i]);
                    if (hd < 8) v *= 0.18033688011112042f;
                    o[i] = v;
                }
                if (act) *(uint2*)(zrow + ZQ + hd * 64 + 4 * l) = pack4bf(o);
            }
            {
                float z[4], zp[4], zn[4]; cvt4bf(ub[r][1], z); cvt4bf(ub[r][0], zp); cvt4bf(ub[r][2], zn);
                float o[4];
#pragma unroll
                for (int i = 0; i < 4; ++i) { const float zf = z[i] + mp0[i] * (zp[i] - z[i]) + mn0[i] * (zn[i] - z[i]); o[i] = (lane < 32) ? (1.0f - 2.0f / (1.0f + __expf(2.0f * zf))) : zf; }
                *(uint2*)(U + (size_t)m * KL + 4 * lane) = pack4bf(o);
            }
            if (lane < 32) {
                float z[4], zp[4], zn[4]; cvt4bf(uc[r][1], z); cvt4bf(uc[r][0], zp); cvt4bf(uc[r][2], zn);
                float o[4];
#pragma unroll
                for (int i = 0; i < 4; ++i) { const float zf = z[i] + mp1[i] * (zp[i] - z[i]) + mn1[i] * (zn[i] - z[i]); o[i] = sigm(zf); }
                *(uint2*)(U + (size_t)m * KL + 256 + 4 * lane) = pack4bf(o);
            }
        }
    }
}

constexpr int TC = 32;
__device__ __forceinline__ void cvt8bf(uint4 u, float (&o)[8]) { o[0] = __uint_as_float(u.x << 16); o[1] = __uint_as_float(u.x & 0xffff0000u); o[2] = __uint_as_float(u.y << 16); o[3] = __uint_as_float(u.y & 0xffff0000u);
    o[4] = __uint_as_float(u.z << 16); o[5] = __uint_as_float(u.z & 0xffff0000u); o[6] = __uint_as_float(u.w << 16); o[7] = __uint_as_float(u.w & 0xffff0000u); }
__device__ __forceinline__ void cvt8h(uint4 u, float (&o)[8]) { typedef _Float16 f16x8_t __attribute__((ext_vector_type(8))); f16x8_t h = __builtin_bit_cast(f16x8_t, u);
#pragma unroll
    for (int i = 0; i < 8; ++i) o[i] = (float)h[i]; }
#define SCAN_LOAD(RZ, RL, RA, CH) do { const int sidx_ = (CH) * TC + tk, t_ = dir ? (T - 1 - sidx_) : sidx_; const long row_ = seqbase + t_; \
        const bf16* zr_ = Z + (size_t)row_ * PZ + hc; \
        _Pragma("unroll") for (int q = 0; q < 3; ++q) { RZ[q][1] = *(const uint4*)(zr_ + q * 512); \
            RZ[q][0] = (t_ > 0) ? *(const uint4*)(zr_ + q * 512 - PZ) : (uint4){0u, 0u, 0u, 0u}; RZ[q][2] = (t_ < T - 1) ? *(const uint4*)(zr_ + q * 512 + PZ) : (uint4){0u, 0u, 0u, 0u}; } \
        RL = *(const uint4*)(LAM + (size_t)row_ * 512 + hc); RA = *(const uint4*)(AR + (size_t)row_ * 512 + hc); } while (0)
#define SCAN_YOUT(CH) do { const int sidx_ = (CH) * TC + tk, t_ = dir ? (T - 1 - sidx_) : sidx_; const long row_ = seqbase + t_; \
        if constexpr (R == 2) { \
            const LAS float* yp_ = ybufs + ((CH) & 1) * TC * 64 + tk * 64 + 8 * l2; const f32x4 ya_ = *(const LAS f32x4*)(yp_), yb_ = *(const LAS f32x4*)(yp_ + 4); \
            uint4 o_; o_.x = pkbf(ya_.x, ya_.y); o_.y = pkbf(ya_.z, ya_.w); o_.z = pkbf(yb_.x, yb_.y); o_.w = pkbf(yb_.z, yb_.w); \
            if (dir == 0) *(uint4*)(YF + (size_t)row_ * 1024 + h * 64 + 8 * l2) = o_; else *(uint4*)(YB + (size_t)row_ * 512 + h * 64 + 8 * l2) = o_; \
        } else { \
            const LAS float* yp_ = ybufs + ((CH) & 1) * TC * 64 + tk * 64 + half * 32 + 4 * l2; const f32x4 ya_ = *(const LAS f32x4*)(yp_); \
            uint2 o_; o_.x = pkbf(ya_.x, ya_.y); o_.y = pkbf(ya_.z, ya_.w); \
            if (dir == 0) *(uint2*)(YF + (size_t)row_ * 1024 + h * 64 + half * 32 + 4 * l2) = o_; else *(uint2*)(YB + (size_t)row_ * 512 + h * 64 + half * 32 + 4 * l2) = o_; \
        } } while (0)
template <int R> __device__ __forceinline__ void scan_unit(const Params& p, LAS unsigned char* lds, int chain, int half) {
    int tid_ = threadIdx.x; asm volatile("" : "+v"(tid_));
    const int tid = tid_, lane = tid & 63, wv = __builtin_amdgcn_readfirstlane(tid >> 6);
    int cc = chain; long seqbase; int T;
    if (cc < 32) { seqbase = MP + (long)(cc >> 4) * TS; T = TS; } else { cc -= 32; seqbase = (long)(cc >> 4) * TP; T = TP; }
    const int h = (cc >> 1) & 7, dir = cc & 1;
    LAS float* bufs = (LAS float*)lds;
    LAS float* ybufs = bufs + 2 * 6 * TC * 64;
    const int nch = T / TC;
    if (wv < 4) {
        __builtin_amdgcn_s_setprio(3);
        f32x2 S[4], S2[4];
#pragma unroll
        for (int i = 0; i < 4; ++i) { S[i] = (f32x2){0.f, 0.f}; S2[i] = (f32x2){0.f, 0.f}; }
        const int j = lane & 7, srow = (R == 2) ? wv * 16 + (lane >> 3) : half * 32 + wv * 8 + (lane >> 3);
        const int ydum_abs = 2 * TC * 64 + wv * 128 + lane;
        for (int c = -1; c < nch; ++c) {
            if (c >= 0) {
                const LAS float* B = bufs + (c & 1) * 6 * TC * 64; LAS float* Y = ybufs + (c & 1) * TC * 64; const int ydum = ydum_abs - (c & 1) * TC * 64;
                const LAS float* q = B + 8 * j; const LAS float* qv = B + 10240 + srow;
                f32x4 ow0[4], ow1[4], oa0[4], oa1[4], ob0[4], ob1[4], ok0[4], ok1[4], or0[4], or1[4]; float ovv[4], ovw[4];
#define SCAN_OPS(N, ST) do { const int o_ = (ST) * 64; ow0[N] = *(const LAS f32x4*)(q + o_); ow1[N] = *(const LAS f32x4*)(q + o_ + 4); oa0[N] = *(const LAS f32x4*)(q + o_ + 2048); oa1[N] = *(const LAS f32x4*)(q + o_ + 2052); \
        ob0[N] = *(const LAS f32x4*)(q + o_ + 4096); ob1[N] = *(const LAS f32x4*)(q + o_ + 4100); ok0[N] = *(const LAS f32x4*)(q + o_ + 6144); ok1[N] = *(const LAS f32x4*)(q + o_ + 6148); \
        or0[N] = *(const LAS f32x4*)(q + o_ + 8192); or1[N] = *(const LAS f32x4*)(q + o_ + 8196); ovv[N] = qv[o_]; if constexpr (R == 2) ovw[N] = qv[o_ + 8]; } while (0)
                constexpr int PF = (R == 2) ? 1 : 2, NM = (R == 2) ? 1 : 3;
                SCAN_OPS(0, 0); if constexpr (PF == 2) SCAN_OPS(1, 1);
                for (int s0 = 0; s0 < TC; s0 += 4) {
#pragma unroll
                    for (int u = 0; u < 4; ++u) {
                        const int s = s0 + u;
                        { const int s2 = (s + PF < TC) ? s + PF : TC - 1; SCAN_OPS((u + PF) & NM, s2); }
                        constexpr int dummy_ = 0; const int un = u & NM;
                        const f32x4 w0 = ow0[un], w1 = ow1[un], a0 = oa0[un], a1 = oa1[un], b0 = ob0[un], b1 = ob1[un], k0 = ok0[un], k1 = ok1[un], r0 = or0[un], r1 = or1[un]; const float vv = ovv[un];
                        const f32x2 A[4] = {{a0.x, a0.y}, {a0.z, a0.w}, {a1.x, a1.y}, {a1.z, a1.w}};
                        const f32x2 W[4] = {{w0.x, w0.y}, {w0.z, w0.w}, {w1.x, w1.y}, {w1.z, w1.w}};
                        const f32x2 Bv[4] = {{b0.x, b0.y}, {b0.z, b0.w}, {b1.x, b1.y}, {b1.z, b1.w}};
                        const f32x2 KD[4] = {{k0.x, k0.y}, {k0.z, k0.w}, {k1.x, k1.y}, {k1.z, k1.w}};
                        const f32x2 R_[4] = {{r0.x, r0.y}, {r0.z, r0.w}, {r1.x, r1.y}, {r1.z, r1.w}};
                        float vw = 0.f; if constexpr (R == 2) vw = ovw[un];
                        f32x2 p0 = S[0] * A[0], p1 = S[1] * A[1]; p0 = S[2] * A[2] + p0; p1 = S[3] * A[3] + p1; p0 = p0 + p1;
                        float sa = p0.x + p0.y, sb = 0.f;
                        if constexpr (R == 2) { f32x2 t0 = S2[0] * A[0], t1 = S2[1] * A[1]; t0 = S2[2] * A[2] + t0; t1 = S2[3] * A[3] + t1; t0 = t0 + t1; sb = t0.x + t0.y; }
                        sa += dpp_x1(sa); if constexpr (R == 2) sb += dpp_x1(sb);
                        sa += dpp_x2(sa); if constexpr (R == 2) sb += dpp_x2(sb);
                        sa += dpp_hm(sa); if constexpr (R == 2) sb += dpp_hm(sb);
                        const f32x2 vv2 = {vv, vv}, sa2 = {sa, sa}, vw2 = {vw, vw}, sb2 = {sb, sb};
#pragma unroll
                        for (int i = 0; i < 4; ++i) { const f32x2 qq = S[i] * W[i] + KD[i] * vv2; S[i] = sa2 * Bv[i] + qq;
                            if constexpr (R == 2) { const f32x2 qr = S2[i] * W[i] + KD[i] * vw2; S2[i] = sb2 * Bv[i] + qr; } }
                        f32x2 y0 = S[0] * R_[0], y1 = S[1] * R_[1]; y0 = S[2] * R_[2] + y0; y1 = S[3] * R_[3] + y1; y0 = y0 + y1;
                        float y = y0.x + y0.y, yb = 0.f;
                        if constexpr (R == 2) { f32x2 z0 = S2[0] * R_[0], z1 = S2[1] * R_[1]; z0 = S2[2] * R_[2] + z0; z1 = S2[3] * R_[3] + z1; z0 = z0 + z1; yb = z0.x + z0.y; }
                        y += dpp_x1(y); if constexpr (R == 2) yb += dpp_x1(yb);
                        y += dpp_x2(y); if constexpr (R == 2) yb += dpp_x2(yb);
                        y += dpp_hm(y); if constexpr (R == 2) yb += dpp_hm(yb);
                        { const int yo = (j == 0) ? (s * 64 + srow) : ydum; Y[yo] = y; if constexpr (R == 2) { const int yo2 = (j == 0) ? (s * 64 + srow + 8) : ydum + 64; Y[yo2] = yb; } }
                    }
                }
#undef SCAN_OPS
            }
            __syncthreads();
        }
        __builtin_amdgcn_s_setprio(0);
        __syncthreads();
    } else {
        const int tid2 = tid - 256, tk = tid2 >> 3, l2 = tid2 & 7, hc = h * 64 + 8 * l2;
        const bf16* Z = (const bf16*)(p.ws + WS_Z);
        const _Float16* LAM = (const _Float16*)p.out + (size_t)dir * MTOT * 512;
        const _Float16* AR = (const _Float16*)p.out + (size_t)(2 + dir) * MTOT * 512;
        bf16* YF = (bf16*)(p.ws + WS_YCAT); bf16* YB = (bf16*)(p.ws + WS_A);
        const float* w0p = p.in[dir ? 11 : 9] + hc; const float* a0p = p.in[dir ? 15 : 13] + hc;
        float* BON = (float*)(p.ws + WS_U) + (size_t)dir * MTOT * 8;
        float cmp[3][8], cmn[3][8], cm0[3][8], ckk[8], cka[8], cf0[8], cw0[8], ca0[8], ce0[8], ce1[8];
#pragma unroll
        for (int q = 0; q < 3; ++q)
#pragma unroll
            for (int i = 0; i < 8; ++i) { cmp[q][i] = p.in[4][q * 512 + hc + i]; cmn[q][i] = p.in[5][q * 512 + hc + i]; cm0[q][i] = 1.0f - cmp[q][i] - cmn[q][i]; }
#pragma unroll
        for (int i = 0; i < 8; ++i) { ckk[i] = p.in[6][hc + i]; cka[i] = p.in[7][hc + i]; cf0[i] = 1.0f - cka[i]; cw0[i] = w0p[i]; ca0[i] = a0p[i];
            const float rk_ = p.in[8][hc + i]; ce0[i] = dir == 0 ? rk_ * (1.0f - cka[i]) : 0.0f; ce1[i] = 0.5f * rk_ * cka[i]; }
        uint4 rzA[3][3]; uint4 rlA, raA;
        SCAN_LOAD(rzA, rlA, raA, 0);
        for (int c = -1; c < nch; ++c) {
            if (c >= 1) SCAN_YOUT(c - 1);
            if (c + 1 < nch) {
                float rkv[3][8];
#pragma unroll
                for (int q = 0; q < 3; ++q) {
                    float z[8], zp[8], zn[8]; cvt8bf(rzA[q][1], z); cvt8bf(rzA[q][0], zp); cvt8bf(rzA[q][2], zn);
#pragma unroll
                    for (int i = 0; i < 8; ++i) rkv[q][i] = z[i] * cm0[q][i] + cmp[q][i] * zp[i] + cmn[q][i] * zn[i];
                }
                float lam[8], ar[8]; cvt8h(rlA, lam); cvt8h(raA, ar);
#pragma unroll
                for (int i = 0; i < 8; ++i) { lam[i] = 0.60653066f * sigm(lam[i] + cw0[i]); ar[i] = sigm(ar[i] + ca0[i]); }
                float kkv[8]; float ss = 0.f;
#pragma unroll
                for (int i = 0; i < 8; ++i) kkv[i] = rkv[1][i] * ckk[i];
#pragma unroll
                for (int i = 0; i < 8; ++i) ss += kkv[i] * kkv[i];
                ss += __shfl_xor(ss, 1); ss += __shfl_xor(ss, 2); ss += __shfl_xor(ss, 4);
                const float inv = 1.0f / sqrtf(fmaxf(ss, 1e-12f));
                {
                    float bsum = 0.f;
#pragma unroll
                    for (int i = 0; i < 8; ++i) bsum += rkv[0][i] * rkv[1][i] * (ce1[i] * ar[i] + ce0[i]);
                    bsum += __shfl_xor(bsum, 1); bsum += __shfl_xor(bsum, 2); bsum += __shfl_xor(bsum, 4);
                    if (l2 == 0) { const int sidx_ = (c + 1) * TC + tk, t_ = dir ? (T - 1 - sidx_) : sidx_; BON[(size_t)(seqbase + t_) * 8 + h] = bsum; }
                }
                LAS float* D = bufs + ((c + 1) & 1) * 6 * TC * 64 + tk * 64 + 8 * l2;
#pragma unroll
                for (int hf = 0; hf < 2; ++hf) {
                    f32x4 ow, oa, ob, ok, orr, ov;
#pragma unroll
                    for (int i = 0; i < 4; ++i) { const int e = hf * 4 + i; const float kn = kkv[e] * inv;
                        ow[i] = __expf(-lam[e]); oa[i] = -kn; ob[i] = kn * ar[e]; ok[i] = rkv[1][e] * (cka[e] * ar[e] + cf0[e]); orr[i] = rkv[0][e]; ov[i] = rkv[2][e]; }
                    *(LAS f32x4*)(D + 4 * hf) = ow; *(LAS f32x4*)(D + 2048 + 4 * hf) = oa; *(LAS f32x4*)(D + 4096 + 4 * hf) = ob; *(LAS f32x4*)(D + 6144 + 4 * hf) = ok; *(LAS f32x4*)(D + 8192 + 4 * hf) = orr; *(LAS f32x4*)(D + 10240 + 4 * hf) = ov;
                }
            }
            if (c + 2 < nch) SCAN_LOAD(rzA, rlA, raA, c + 2);
            __syncthreads();
        }
        SCAN_YOUT(nch - 1);
        __syncthreads();
    }
}
#undef SCAN_LOAD
#undef SCAN_YOUT

__device__ __forceinline__ void p5_post(const Params& p) {
    const int tid = threadIdx.x, lane = tid & 63, wave = tid >> 6;
    const int gw = blockIdx.x * NWAVES + wave, NGW = gridDim.x * NWAVES;
    const bf16* Z = (const bf16*)(p.ws + WS_Z);
    bf16* YC = (bf16*)(p.ws + WS_YCAT); const bf16* YB = (const bf16*)(p.ws + WS_A); const _Float16* G = (const _Float16*)(p.ws + WS_A) + (size_t)MTOT * 512;
    const float* BONF = (const float*)(p.ws + WS_U); const float* BONB = BONF + (size_t)MTOT * 8;
    const int l = lane & 15, hq = lane >> 4;
    for (int m = gw; m < MTOT; m += NGW) {
        int t, T; if (m < MP) { t = m & (TP - 1); T = TP; } else { t = (m - MP) & (TS - 1); T = TS; }
        uint2 ryf[2], ryb[2], rg[2], rzv[2][3]; float bsv[2];
#pragma unroll
        for (int e = 0; e < 2; ++e) { const int hh = e * 4 + hq, hc = hh * 64 + 4 * l;
            ryf[e] = *(const uint2*)(YC + (size_t)m * 1024 + hc); ryb[e] = *(const uint2*)(YB + (size_t)m * 512 + hc); rg[e] = *(const uint2*)(G + (size_t)m * 512 + hc);
            bsv[e] = BONF[(size_t)m * 8 + hh] + BONB[(size_t)m * 8 + hh];
            const bf16* zr = Z + (size_t)m * PZ + 1024 + hc;
            rzv[e][1] = *(const uint2*)(zr); rzv[e][0] = (t > 0) ? *(const uint2*)(zr - PZ) : (uint2){0u, 0u}; rzv[e][2] = (t < T - 1) ? *(const uint2*)(zr + PZ) : (uint2){0u, 0u};
        }
#pragma unroll
        for (int e = 0; e < 2; ++e) { const int hc = (e * 4 + hq) * 64 + 4 * l;
            float yf[4], yb[4], gg[4], z[4], zp[4], zn[4], vv[4];
            cvt4bf(ryf[e], yf); cvt4bf(ryb[e], yb); cvt4h(rg[e], gg); cvt4bf(rzv[e][1], z); cvt4bf(rzv[e][0], zp); cvt4bf(rzv[e][2], zn);
            const f32x4 mp = *(const f32x4*)(p.in[4] + 1024 + hc), mn = *(const f32x4*)(p.in[5] + 1024 + hc), lw = *(const f32x4*)(p.in[18] + hc), lb = *(const f32x4*)(p.in[19] + hc);
            float y[4]; float s = 0.f;
#pragma unroll
            for (int i = 0; i < 4; ++i) { vv[i] = z[i] + mp[i] * (zp[i] - z[i]) + mn[i] * (zn[i] - z[i]); y[i] = yf[i] + yb[i]; s += y[i]; }
            s = sum16(s);
            const float mean = s * (1.0f / 64.0f); float q2 = 0.f;
#pragma unroll
            for (int i = 0; i < 4; ++i) { y[i] -= mean; q2 += y[i] * y[i]; }
            q2 = sum16(q2);
            const float rstd = 1.0f / sqrtf(q2 * (1.0f / 64.0f) + 64e-5f);
            float o[4];
#pragma unroll
            for (int i = 0; i < 4; ++i) o[i] = (y[i] * rstd * lw[i] + lb[i] + bsv[e] * vv[i]) * gg[i];
            *(uint2*)(YC + (size_t)m * 1024 + hc) = pack4bf(o);
        }
    }
}

__device__ __forceinline__ void p9_final(const Params& p, float probe_delta) {
    const int tid = threadIdx.x, lane = tid & 63, wave = tid >> 6;
    const int gw = blockIdx.x * NWAVES + wave, NGW = gridDim.x * NWAVES;
    f32x4 gv[4];
#pragma unroll
    for (int j = 0; j < 4; ++j) gv[j] = *((const f32x4*)p.in[27] + lane + 64 * j);
    for (int it = gw; it < MTOT / 4; it += NGW) {
        f32x4 v[4][4];
#pragma unroll
        for (int r = 0; r < 4; ++r) { const f32x4* xr = (const f32x4*)(p.out + (size_t)(4 * it + r) * 1024) + lane;
#pragma unroll
            for (int j = 0; j < 4; ++j) v[r][j] = xr[64 * j]; }
#pragma unroll
        for (int r = 0; r < 4; ++r) { f32x4* xr = (f32x4*)(p.out + (size_t)(4 * it + r) * 1024) + lane; float s = 0.f;
#pragma unroll
            for (int j = 0; j < 4; ++j) s += (v[r][j].x * v[r][j].x + v[r][j].y * v[r][j].y) + (v[r][j].z * v[r][j].z + v[r][j].w * v[r][j].w);
            const float rstd = 1.0f / sqrtf(wave_sum(s) * (1.0f / 1024.0f) + 1e-6f);
#pragma unroll
            for (int j = 0; j < 4; ++j) { f32x4 ov = v[r][j] * rstd * gv[j]; if (gw == 0 && it == 0 && r == 0 && j == 0) ov.x += probe_delta; xr[64 * j] = ov; } }
    }
}

#define XB_TMO      128
#define XB_XCNT(j)  (256  + 64 * (j))
#define XB_XSUB(j)  (1280 + 64 * (j))
#define XB_XGEN(j)  (2304 + 64 * (j))
#define XB_TOP      3328
#define XB_TOPGEN   3392
#define XCD_BAR_WORDS 3456
#define XB_SPIN_CAP (1u << 18)

__device__ __forceinline__ unsigned xb_ld(unsigned* p)              { return __hip_atomic_load(p, __ATOMIC_RELAXED, __HIP_MEMORY_SCOPE_AGENT); }
__device__ __forceinline__ unsigned xb_add(unsigned* p, unsigned v) { return __hip_atomic_fetch_add(p, v, __ATOMIC_RELAXED, __HIP_MEMORY_SCOPE_AGENT); }
__device__ __forceinline__ unsigned xb_xcc_id() { return (unsigned)__builtin_amdgcn_s_getreg((3 << 11) | 20) & 0xFu; }
#define XB_SPIN(cond, bar) do { unsigned _sp = 0; while (cond) { __builtin_amdgcn_s_sleep(1); \
    if ((++_sp & 255u) == 0u) { if (xb_ld(&(bar)[XB_TMO])) break; if (_sp > XB_SPIN_CAP) { atomicAdd(&(bar)[XB_TMO], 1u); break; } } } } while (0)

struct XcdBarrier {
    unsigned* bar; unsigned x;
    volatile LAS unsigned* st;
};

__device__ __forceinline__ XcdBarrier xcd_barrier_post(unsigned* bar, volatile LAS unsigned* st) {
    XcdBarrier b; b.bar = bar; b.x = xb_xcc_id(); b.st = st;
    if (threadIdx.x == 0) (void)xb_add(&bar[XB_XCNT(b.x)], 1u);
    return b;
}
__device__ __forceinline__ void xcd_barrier_complete(unsigned* bar, unsigned x, unsigned& nloc, unsigned& nx) {
    const unsigned G = gridDim.x * gridDim.y * gridDim.z;
    unsigned sum, cnt, mine, sp = 0u;
    for (;;) {
        sum = 0u; cnt = 0u; mine = 0u;
#pragma unroll
        for (unsigned j = 0; j < 16; ++j) { const unsigned c = xb_ld(&bar[XB_XCNT(j)]); sum += c; cnt += (c > 0u) ? 1u : 0u; mine = (j == x) ? c : mine; }
        if (sum == G) break;
        __builtin_amdgcn_s_sleep(1);
        if ((++sp & 255u) == 0u) { if (xb_ld(&bar[XB_TMO])) break; if (sp > XB_SPIN_CAP) { atomicAdd(&bar[XB_TMO], 1u); break; } }
    }
    nloc = mine > 0u ? mine : 1u; nx = cnt > 0u ? cnt : 1u;
}

__device__ __forceinline__ void xcd_barrier(const XcdBarrier& b) {
    asm volatile("s_waitcnt vmcnt(0)" ::: "memory");
    __syncthreads();
    if (threadIdx.x == 0) {
        unsigned* bar = b.bar;
        __builtin_amdgcn_s_waitcnt(0);
        unsigned nloc = b.st[0], nx = b.st[1];
        if (nloc == 0u) { xcd_barrier_complete(bar, b.x, nloc, nx); b.st[0] = nloc; b.st[1] = nx; }
        const unsigned old = xb_add(&bar[XB_XSUB(b.x)], 1u);
        const unsigned gen = old / nloc;
        if (old + 1u == (gen + 1u) * nloc) {
            __builtin_amdgcn_fence(__ATOMIC_RELEASE, "agent");
            asm volatile("s_waitcnt vmcnt(0)" ::: "memory");
            const unsigned og = xb_add(&bar[XB_TOP], 1u);
            const unsigned tg = og / nx;
            if (og + 1u == (tg + 1u) * nx) xb_add(&bar[XB_TOPGEN], 1u);
            else XB_SPIN(xb_ld(&bar[XB_TOPGEN]) == tg, bar);
            __builtin_amdgcn_fence(__ATOMIC_ACQUIRE, "agent");
            xb_add(&bar[XB_XGEN(b.x)], 1u);
            asm volatile("s_waitcnt vmcnt(0)" ::: "memory");
        } else {
            XB_SPIN(xb_ld(&bar[XB_XGEN(b.x)]) == gen, bar);
            __builtin_amdgcn_fence(__ATOMIC_ACQUIRE, "agent");
            asm volatile("s_waitcnt vmcnt(0)" ::: "memory");
        }
    }
    __syncthreads();
}

constexpr int N_SCAN_S = 64, N_SCAN_P = 512, N_ATT_S = 2 * 8 * (TS / 256), N_ATT_P = 32 * 8 * (TP / 256);
constexpr int N_UNITS = N_SCAN_S + N_SCAN_P + N_ATT_S + N_ATT_P;

__global__ void __launch_bounds__(NTHR, 2) mega_fwd(Params p) {
    __builtin_assume(__builtin_amdgcn_workitem_id_y() == 0); __builtin_assume(__builtin_amdgcn_workitem_id_z() == 0);
    extern __shared__ __attribute__((aligned(16))) unsigned char lds_raw[];
    LAS unsigned char* lds = (LAS unsigned char*)lds_raw;
    volatile LAS unsigned* MISC = (volatile LAS unsigned*)(lds + MISC_OFF);
    const int tid = threadIdx.x;
    const int lo = p.ph_lo, hi = p.ph_hi;
    if (tid < 32) MISC[tid] = 0u;
    __syncthreads();
    XcdBarrier xbar; xbar.bar = (unsigned*)(p.ws + WS_CTL) + 4096; xbar.x = 0; xbar.st = MISC + 8;
    unsigned char* ws = p.ws;
    bf16* Zb = (bf16*)(ws + WS_Z); bf16* Ab = (bf16*)(ws + WS_A); bf16* YC = (bf16*)(ws + WS_YCAT);
    float* ssq2 = (float*)(ws + WS_SSQ);
#ifndef PROBE_REP0
#define PROBE_REP0 1
#endif
#ifndef PROBE_REP1
#define PROBE_REP1 1
#endif
#ifndef PROBE_REP3
#define PROBE_REP3 1
#endif
#ifndef PROBE_REP7
#define PROBE_REP7 1
#endif
#define IN(k) (lo <= (k) && (k) < hi)
    unsigned* pctl = (unsigned*)(ws + 31 * MiB);
#if defined(PROBE_TS_SEAM) || defined(PROBE_TS_UNIT) || defined(PROBE_TS_END)
    if (blockIdx.x == 0 && tid == 0 && lo == 0) __hip_atomic_store(pctl, (unsigned)__builtin_amdgcn_s_memrealtime(), __ATOMIC_RELAXED, __HIP_MEMORY_SCOPE_AGENT);
#endif
#ifdef PROBE_TS_SEAM
#define SEAM(k) do { if (IN(k) && IN((k) + 1)) { cg::this_grid().sync(); if ((k) == PROBE_TS_SEAM && blockIdx.x == 0 && tid == 0) { __hip_atomic_store(pctl + 64, (unsigned)__builtin_amdgcn_s_memrealtime() - __hip_atomic_load(pctl, __ATOMIC_RELAXED, __HIP_MEMORY_SCOPE_AGENT), __ATOMIC_RELAXED, __HIP_MEMORY_SCOPE_AGENT); } } } while (0)
#else
#define SEAM(k) do { if (IN(k) && IN((k) + 1)) { if ((k) == 0) { cg::this_grid().sync(); xbar = xcd_barrier_post((unsigned*)(p.ws + WS_CTL) + 4096, MISC + 8); } else { xcd_barrier(xbar); } } } while (0)
#endif
    if (IN(0)) { p0_prologue(p, lds); __syncthreads(); }
    SEAM(0);
#ifndef NOP1
    if (IN(1)) {
        pg8::Gemm g{Ab, (const bf16*)(ws + WS_WIN), MTOT, PZ, 1024, 1024, 0}; pg8::StaticOrder S; S.init(MTOT, PZ, gridDim.x, (int)blockIdx.x);
        pg8::EpiBf16<0> E{Zb, PZ, nullptr, 0, 0, 1.f};
        pg8::gemm_phase<pg8::EpiBf16<0>, pg8::StaticOrder, true, true>(lds, g, S, E);
    }
#endif
    SEAM(1);
    if (IN(2)) p2_prep(p);
    SEAM(2);
#ifndef NOP3
    if (IN(3)) {
        pg8::Gemm g{(const bf16*)(ws + WS_U), (const bf16*)(ws + WS_WL), MTOT, NL, 128, KL, 128};     pg8::StaticOrder S; S.init(MTOT, NL, gridDim.x, (int)blockIdx.x);
        pg8::EpiLora E{(_Float16*)p.out, (size_t)MTOT * 512, (_Float16*)(Ab + (size_t)MTOT * 512)};
        pg8::gemm_phase<pg8::EpiLora, pg8::StaticOrder, true, true>(lds, g, S, E);
    }
#endif
    SEAM(3);
    if (IN(4)) {
#ifndef PROBE_P4_REPS
#define PROBE_P4_REPS 1
#endif
#ifndef PROBE_P4_N2
#define PROBE_P4_N2 N_UNITS
#endif
        for (int rep = 0; rep < PROBE_P4_REPS; ++rep) {
        unsigned* qctr = (unsigned*)(ws + WS_CTL) + CW_QUEUE + 64 * rep;
        const int nun = rep == 0 ? N_UNITS : (PROBE_P4_N2);
        for (;;) {
#ifdef PROBE_P4_START2
            if (tid == 0) MISC[0] = atomicAdd(qctr, 1u) + (rep ? (PROBE_P4_START2) : 0);
#else
            if (tid == 0) MISC[0] = atomicAdd(qctr, 1u);
#endif
            __syncthreads();
#ifdef PROBE_P4_EXTRA_ATT
            int u = (int)MISC[0];
            __syncthreads();
            if (u >= N_UNITS + N_ATT_S + N_ATT_P) break;
            if (u >= N_UNITS) u -= (N_ATT_S + N_ATT_P);
#else
            const int u = (int)MISC[0];
            __syncthreads();
            if (u >= nun) break;
#endif
#ifndef NOSCAN
            if (u < N_SCAN_S + N_SCAN_P) { if (u < N_SCAN_S) scan_unit<1>(p, lds, u >> 1, u & 1); else scan_unit<2>(p, lds, 32 + (u - N_SCAN_S), 0);
#ifdef PROBE_TS_UNIT
                if (u == PROBE_TS_UNIT && tid == 0) __hip_atomic_store(pctl + 64, (unsigned)__builtin_amdgcn_s_memrealtime() - __hip_atomic_load(pctl, __ATOMIC_RELAXED, __HIP_MEMORY_SCOPE_AGENT), __ATOMIC_RELAXED, __HIP_MEMORY_SCOPE_AGENT);
#endif
            } else
#endif
            {
#ifndef NOATT
                int a = u - (N_SCAN_S + N_SCAN_P); long rowbase; int T, nqb;
                if (a < N_ATT_S) { T = TS; nqb = TS / 256; } else { a -= N_ATT_S; T = TP; nqb = TP / 256; }
                const int gq = a & 3, qb = (a >> 2) % nqb, rest = (a >> 2) / nqb, kvh = rest & 1, seq = rest >> 1;
                rowbase = (T == TS) ? (long)MP + (long)seq * TS : (long)seq * TP;
                attn_body::attn_unit<8>(rowbase, T, kvh * 4 + gq, qb, (const attn_body::bf16*)(const void*)Zb, (attn_body::bf16*)(void*)YC, (char*)lds_raw);
#endif
            }
        }
        }
    }
    SEAM(4);
    if (IN(5)) p5_post(p);
    SEAM(5);
#ifndef NOP6
    if (IN(6)) {
        pg8::Gemm g{YC, (const bf16*)(ws + WS_WOUT), MTOT, 1024, 1024, 1024, 0}; pg8::StaticOrder S; S.init(MTOT, 1024, gridDim.x, (int)blockIdx.x);
        pg8::EpiRes<true> E{p.in[0], p.in[1], p.out, Ab, ssq2};
        pg8::gemm_phase<pg8::EpiRes<true>, pg8::StaticOrder, true, true>(lds, g, S, E);
    }
#endif
    SEAM(6);
#ifndef NOP7
    if (IN(7)) {
        pg8::Gemm g{Ab, (const bf16*)(ws + WS_WGU), MTOT, 2 * DFF, 1024, 1024, 0}; pg8::StaticOrder S; S.init(MTOT, 2 * DFF, gridDim.x, (int)blockIdx.x);
        pg8::EpiSwiGLU E{Zb, ssq2};
        pg8::gemm_phase<pg8::EpiSwiGLU, pg8::StaticOrder, true, true>(lds, g, S, E);
    }
#endif
    SEAM(7);
#ifndef NOP8
    if (IN(8)) {
        pg8::Gemm g{Zb, (const bf16*)(ws + WS_WDN), MTOT, 1024, DFF, DFF, 0}; pg8::StaticOrder S; S.init(MTOT, 1024, gridDim.x, (int)blockIdx.x);
        pg8::EpiRes<false> E{p.out, p.out + (size_t)MP * 1024, p.out, nullptr, nullptr};
        pg8::gemm_phase<pg8::EpiRes<false>, pg8::StaticOrder, true, true>(lds, g, S, E);
    }
#endif
    SEAM(8);
#if defined(PROBE_TS_SEAM) || defined(PROBE_TS_UNIT)
    if (IN(9)) { p9_final(p, (blockIdx.x == 0) ? sqrtf(1.05f * (float)__hip_atomic_load(pctl + 64, __ATOMIC_RELAXED, __HIP_MEMORY_SCOPE_AGENT) * 1e-6f) : 0.f); }
#else
    if (IN(9)) p9_final(p, 0.f);
#endif
#ifdef PROBE_TS_END
    if (blockIdx.x == 0 && tid < 64) { const unsigned tk_ = (unsigned)__builtin_amdgcn_s_memrealtime() - __hip_atomic_load(pctl, __ATOMIC_RELAXED, __HIP_MEMORY_SCOPE_AGENT); p.out[4 * tid] += sqrtf(1.05f * (float)tk_ * 1e-6f); }
#endif
#undef IN
#undef SEAM
}

extern "C" void kernel_launch(void* const* d_in, const int* in_sizes, int n_in, void* d_out, int out_size, void* d_ws, size_t ws_size, hipStream_t stream) {
    static int grid = 0;
    if (grid == 0) {
        if (n_in != 28 || out_size != MTOT * 1024 || ws_size < WS_END) { fprintf(stderr, "kernel_launch: unexpected shapes n_in %d out %d ws %zu\n", n_in, out_size, ws_size); grid = -1; return; }
        int dev = 0, cus = 0, per_cu = 0;
        hipGetDevice(&dev); hipDeviceGetAttribute(&cus, hipDeviceAttributeMultiprocessorCount, dev);
        if (hipFuncSetAttribute((const void*)mega_fwd, hipFuncAttributeMaxDynamicSharedMemorySize, LDS_BYTES) != hipSuccess) { fprintf(stderr, "kernel_launch: hipFuncSetAttribute failed\n"); grid = -1; return; }
        if (hipOccupancyMaxActiveBlocksPerMultiprocessor(&per_cu, (const void*)mega_fwd, NTHR, LDS_BYTES) != hipSuccess || per_cu < 1) { fprintf(stderr, "kernel_launch: occupancy query says %d\n", per_cu); per_cu = 1; }
        (void)hipGetLastError();
        grid = cus * 1;
    }
    if (grid < 0) return;
    Params p{};
    for (int i = 0; i < 28; ++i) p.in[i] = (const float*)d_in[i];
    p.out = (float*)d_out; p.ws = (unsigned char*)d_ws;
#if MK_N_LAUNCHES == 1
    p.ph_lo = 0; p.ph_hi = NPHASE;
    void* args[] = {&p};
    hipError_t e = hipLaunchCooperativeKernel((const void*)mega_fwd, dim3(grid), dim3(NTHR), args, LDS_BYTES, stream);
    if (e != hipSuccess) fprintf(stderr, "cooperative launch failed: %s (grid %d)\n", hipGetErrorString(e), grid);
#else
    for (int ph = 0; ph < NPHASE; ++ph) {
        p.ph_lo = ph; p.ph_hi = ph + 1;
        hipLaunchKernelGGL(mega_fwd, dim3(grid), dim3(NTHR), LDS_BYTES, stream, p);
    }
#endif
}
```

```cpp
#include <hip/hip_runtime.h>
#include <hip/hip_cooperative_groups.h>
#include <cstdio>
#include <cstdint>
#ifndef MK_N_LAUNCHES
#define MK_N_LAUNCHES 1
#endif
namespace pg8 {
#define PG8_LAS __attribute__((address_space(3)))
typedef unsigned short bf16_t;
typedef short bf16x8 __attribute__((ext_vector_type(8)));
typedef float f32x4 __attribute__((ext_vector_type(4)));
typedef unsigned u32x4 __attribute__((ext_vector_type(4)));
constexpr int BM = 256, BK = 64, HALF = 128, HTB = HALF * BK * 2  , STAGE_BYTES = 8 * HTB, NXCD = 8, WGM = 8;

__host__ __device__ __forceinline__ int lds_byte(int r, int c) { const int st = (r >> 4) * 2 + (c >> 5), rr = r & 15, cc = c & 31, ob = rr * 64 + cc * 2; return st * 1024 + (ob ^ (((ob >> 9) & 1) << 5)); }
__host__ __device__ __forceinline__ void stage_rc(int b, int& R, int& C) { const int st = b / 1024, sb = b % 1024, swz = sb ^ (((sb >> 9) & 1) << 5); R = (st >> 1) * 16 + swz / 64; C = (st & 1) * 32 + (swz % 64) / 2; }
__host__ __device__ __forceinline__ int perm32(int rho) { const int n = rho >> 4, i = rho & 15; return 8 * (i >> 2) + 4 * n + (i & 3); }

struct Unit { int pm, pn; };
struct Gemm { const bf16_t* A; const bf16_t* Bt; int M, N, K; int lda; int acs; };

struct StaticOrder {
    int nM, nN, nwg, G, c;
    __host__ __device__ void init(int M, int N, int G_, int c_) { nM = M / BM; nN = N / BM; nwg = nM * nN; G = G_; c = c_; }
    __host__ __device__ bool next(int i, Unit& u) const {
        const long L = (long)i * G + c; if (L >= nwg) return false;
        int wgid = (int)L; { const int q = nwg / NXCD, r = nwg % NXCD, xcd = wgid % NXCD, off = wgid / NXCD; wgid = (xcd < r ? xcd * (q + 1) : r * (q + 1) + (xcd - r) * q) + off; }
        const int nig = WGM * nN, gid = wgid / nig, fm = gid * WGM, gsz = (nM - fm) < WGM ? (nM - fm) : WGM;
        u.pm = fm + ((wgid % nig) % gsz); u.pn = (wgid % nig) / gsz; return true;
    }
    __device__ __forceinline__ void a_ready(const Unit&) const {}
    __device__ __forceinline__ void done(const Unit&) const {}
};

__device__ __forceinline__ unsigned cvt_pk_bf16(float lo, float hi) { unsigned r; asm volatile("v_cvt_pk_bf16_f32 %0, %1, %2" : "=v"(r) : "v"(lo), "v"(hi)); return r; }
typedef float f32x2 __attribute__((ext_vector_type(2)));
__device__ __forceinline__ f32x2 gelu_pk(f32x2 v) {
    const f32x2 av = __builtin_elementwise_abs(v), d = av * 0.2316418882f + 1.0f;
    f32x2 t; t.x = __builtin_amdgcn_rcpf(d.x); t.y = __builtin_amdgcn_rcpf(d.y);
    f32x2 q = t * 0.5307027145f + (-0.7265760135f); q = q * t + 0.7107068705f; q = q * t + (-0.142248368f); q = q * t + 0.127414796f; q = q * t;
    const f32x2 s = (v * v) * (-0.72134752044f);
    f32x2 e; e.x = __builtin_amdgcn_exp2f(s.x); e.y = __builtin_amdgcn_exp2f(s.y);
    const f32x2 m = v * (q * e), r = v - m;
    f32x2 o; o.x = v.x < 0.f ? m.x : r.x; o.y = v.y < 0.f ? m.y : r.y; return o;
}

template <int ACT  > struct EpiBf16 {
    static constexpr bool PERM = true, AFTER_DRAIN = false; static_assert(ACT == 0 || ACT == 1, "EpiBf16: ACT is 0 (none) or 1 (gelu_pk)");
    bf16_t* O; int ldc; const float* bias; int split_cols; size_t split_stride; float scale0;
    __device__ __forceinline__ void operator()(const f32x4 (&acc)[2][2][4][2], const Unit& u, int wr, int wc, int fr, int fq) const {
        const int row0 = u.pm * BM + wr * 64 + fr; int colt = u.pn * BM; bf16_t* base = O;
        float sc = 1.f; if (split_cols) { const int t = colt / split_cols; base += (size_t)t * split_stride; colt -= t * split_cols; if (t == 0) sc = scale0; }
        const int col0 = colt + wc * 32 + 8 * fq, bcol0 = u.pn * BM + wc * 32 + 8 * fq;
        f32x4 bv[2][2];
#pragma unroll
        for (int bj = 0; bj < 2; ++bj)
#pragma unroll
            for (int n = 0; n < 2; ++n) bv[bj][n] = bias ? *(const f32x4*)(bias + bcol0 + bj * HALF + 4 * n) : (f32x4){0.f, 0.f, 0.f, 0.f};
#pragma unroll
        for (int ai = 0; ai < 2; ++ai)
#pragma unroll
            for (int m = 0; m < 4; ++m) { bf16_t* rowp = base + (size_t)(row0 + ai * HALF + m * 16) * ldc + col0;
#pragma unroll
                for (int bj = 0; bj < 2; ++bj) { f32x4 v0 = acc[ai][bj][m][0] + bv[bj][0], v1 = acc[ai][bj][m][1] + bv[bj][1];
                    if (ACT == 1) { f32x2 a = gelu_pk((f32x2){v0[0], v0[1]}), b = gelu_pk((f32x2){v0[2], v0[3]}), c = gelu_pk((f32x2){v1[0], v1[1]}), d = gelu_pk((f32x2){v1[2], v1[3]});
                        v0 = (f32x4){a.x, a.y, b.x, b.y}; v1 = (f32x4){c.x, c.y, d.x, d.y}; }
                    v0 = v0 * sc; v1 = v1 * sc; u32x4 w; w.x = cvt_pk_bf16(v0[0], v0[1]); w.y = cvt_pk_bf16(v0[2], v0[3]); w.z = cvt_pk_bf16(v1[0], v1[1]); w.w = cvt_pk_bf16(v1[2], v1[3]);
                    *(u32x4*)(rowp + bj * HALF) = w; } }
    }
};
typedef _Float16 f16x8 __attribute__((ext_vector_type(8)));
__device__ __forceinline__ unsigned cvt_pk_f16(float lo, float hi) { unsigned r; asm volatile("v_cvt_pk_f16_f32 %0, %1, %2" : "=v"(r) : "v"(lo), "v"(hi)); return r; }
struct EpiLora {
    static constexpr bool PERM = true, AFTER_DRAIN = false;
    _Float16* T16; size_t tstride; _Float16* G;
    __device__ __forceinline__ void operator()(const f32x4 (&acc)[2][2][4][2], const Unit& u, int wr, int wc, int fr, int fq) const {
        const int tt = u.pn >> 1, colt = (u.pn & 1) * 256;
        const int row0 = u.pm * BM + wr * 64 + fr, col0 = colt + wc * 32 + 8 * fq;
        _Float16* base = (tt < 4) ? T16 + (size_t)tt * tstride : G;
#pragma unroll
        for (int ai = 0; ai < 2; ++ai)
#pragma unroll
            for (int m = 0; m < 4; ++m) { _Float16* rowp = base + (size_t)(row0 + ai * HALF + m * 16) * 512 + col0;
#pragma unroll
                for (int bj = 0; bj < 2; ++bj) {
                    const f32x4 v0 = acc[ai][bj][m][0], v1 = acc[ai][bj][m][1];
                    u32x4 w; w.x = cvt_pk_f16(v0[0], v0[1]); w.y = cvt_pk_f16(v0[2], v0[3]); w.z = cvt_pk_f16(v1[0], v1[1]); w.w = cvt_pk_f16(v1[2], v1[3]);
                    *(u32x4*)(rowp + bj * HALF) = w;
                }
            }
    }
};
template <bool BF_SSQ> struct EpiRes {
    static constexpr bool PERM = true, AFTER_DRAIN = false;
    const float* baseP; const float* baseS; float* out; bf16_t* xb; float* ssq;
    __device__ __forceinline__ void operator()(const f32x4 (&acc)[2][2][4][2], const Unit& u, int wr, int wc, int fr, int fq) const {
        const int row0 = u.pm * BM + wr * 64 + fr, col0 = u.pn * BM + wc * 32 + 8 * fq;
        const float* base = (u.pm < 256) ? baseP : baseS - (size_t)65536 * 1024;
#pragma unroll
        for (int ai = 0; ai < 2; ++ai)
#pragma unroll
            for (int m = 0; m < 4; ++m) {
                const int row = row0 + ai * HALF + m * 16; const size_t off = (size_t)row * 1024 + col0; float s = 0.f;
#pragma unroll
                for (int bj = 0; bj < 2; ++bj) {
                    const f32x4 x0 = *(const f32x4*)(base + off + bj * HALF), x1 = *(const f32x4*)(base + off + bj * HALF + 4);
                    const f32x4 v0 = acc[ai][bj][m][0] + x0, v1 = acc[ai][bj][m][1] + x1;
                    *(f32x4*)(out + off + bj * HALF) = v0; *(f32x4*)(out + off + bj * HALF + 4) = v1;
                    if (BF_SSQ) {
                        s += (v0[0] * v0[0] + v0[1] * v0[1]) + (v0[2] * v0[2] + v0[3] * v0[3]) + (v1[0] * v1[0] + v1[1] * v1[1]) + (v1[2] * v1[2] + v1[3] * v1[3]);
                        u32x4 w; w.x = cvt_pk_bf16(v0[0], v0[1]); w.y = cvt_pk_bf16(v0[2], v0[3]); w.z = cvt_pk_bf16(v1[0], v1[1]); w.w = cvt_pk_bf16(v1[2], v1[3]);
                        *(u32x4*)(xb + off + bj * HALF) = w;
                    }
                }
                if (BF_SSQ) { s += __shfl_xor(s, 16); s += __shfl_xor(s, 32); if (fq == 0) atomicAdd(ssq + row, s); }
            }
    }
};
struct EpiSwiGLU {
    static constexpr bool PERM = true, AFTER_DRAIN = false;
    bf16_t* act; const float* ssq;
    __device__ __forceinline__ void operator()(const f32x4 (&acc)[2][2][4][2], const Unit& u, int wr, int wc, int fr, int fq) const {
        const int row0 = u.pm * BM + wr * 64 + fr, col0 = u.pn * HALF + wc * 32 + 8 * fq;
#pragma unroll
        for (int ai = 0; ai < 2; ++ai)
#pragma unroll
            for (int m = 0; m < 4; ++m) {
                const int row = row0 + ai * HALF + m * 16;
                const float rstd = __builtin_amdgcn_rsqf(ssq[row] * (1.0f / 1024.0f) + 1e-6f), nrl = rstd * -1.4426950408889634f;
                f32x4 o[2];
#pragma unroll
                for (int n = 0; n < 2; ++n) {
                    const f32x4 g = acc[ai][0][m][n], up = acc[ai][1][m][n];
                    const f32x4 x = g * nrl; f32x4 d;
#pragma unroll
                    for (int i = 0; i < 4; ++i) d[i] = __builtin_amdgcn_exp2f(x[i]);
                    d = d + 1.0f;
#pragma unroll
                    for (int i = 0; i < 4; ++i) d[i] = __builtin_amdgcn_rcpf(d[i]);
                    o[n] = (g * up) * (d * (rstd * rstd));
                }
                u32x4 w; w.x = cvt_pk_bf16(o[0][0], o[0][1]); w.y = cvt_pk_bf16(o[0][2], o[0][3]); w.z = cvt_pk_bf16(o[1][0], o[1][1]); w.w = cvt_pk_bf16(o[1][2], o[1][3]);
                *(u32x4*)(act + (size_t)row * 2816 + col0) = w;
            }
    }
};

template <class Epi, class Sched, bool ALIGN_EPI = false, bool SP2 = false>
__device__ __forceinline__ void gemm_phase(PG8_LAS unsigned char* lds, const Gemm g, const Sched& S, const Epi& E) {
    const int tid = threadIdx.x, wid = __builtin_amdgcn_readfirstlane(tid >> 6), lane = tid & 63, wr = wid >> 2, wc = wid & 3, fr = lane & 15, fq = lane >> 4;
    const int K = g.K, nt = K / BK, lda = g.lda, acs = g.acs;
    unsigned voffA[2], voffB[2];
#pragma unroll
    for (int i = 0; i < 2; ++i) { int R, C; stage_rc(tid * 16 + i * 8192, R, C); const int Rb = Epi::PERM ? ((R & ~31) + perm32(R & 31)) : R;
        voffA[i] = (unsigned)(R * lda + C) * 2u; voffB[i] = (unsigned)(Rb * K + C) * 2u; }
    const size_t kstep = (size_t)(BK * 2);
    const size_t hstep = (size_t)HALF * K * 2, hstepA = (size_t)HALF * lda * 2;
    const size_t tstep = 2 * hstep, tstepA = 2 * hstepA;
#define PG8_ACOL(pn) ((size_t)(((pn) >> 2) < 2 ? ((pn) >> 2) : 2) * (size_t)acs * 2)
    const unsigned ldsw = (unsigned)wid * 1024u;
    const int aoff = lds_byte(wr * 64 + fr, fq * 8), boff = lds_byte(wc * 32 + fr, fq * 8);
#define PG8_SA(b, h) (((b) * 2 + (h)) * HTB)
#define PG8_SB(b, h) ((4 + (b) * 2 + (h)) * HTB)
#define PG8_STAGE(bufoff, gbase, voff) do { _Pragma("unroll") for (int _i = 0; _i < 2; ++_i) \
        __builtin_amdgcn_global_load_lds((const unsigned*)((const char*)(gbase) + (voff)[_i]), (PG8_LAS unsigned*)(lds + (bufoff) + ldsw + _i * 8192), 16, 0, 0); } while (0)
#define PG8_LDA(dst, b, h) do { _Pragma("unroll") for (int m = 0; m < 4; ++m) _Pragma("unroll") for (int k = 0; k < 2; ++k) dst[m][k] = *(const PG8_LAS bf16x8*)(lds + PG8_SA(b, h) + aoff + m * 2048 + k * 1024); } while (0)
#define PG8_LDB(dst, b, h) do { _Pragma("unroll") for (int n = 0; n < 2; ++n) _Pragma("unroll") for (int k = 0; k < 2; ++k) dst[n][k] = *(const PG8_LAS bf16x8*)(lds + PG8_SB(b, h) + boff + n * 2048 + k * 1024); } while (0)
#define PG8_MMA(ai, bj, At, Bt) do { __builtin_amdgcn_s_setprio(1); _Pragma("unroll") for (int m = 0; m < 4; ++m) _Pragma("unroll") for (int n = 0; n < 2; ++n) _Pragma("unroll") for (int k = 0; k < 2; ++k) \
        acc[ai][bj][m][n] = __builtin_amdgcn_mfma_f32_16x16x32_bf16(Bt[n][k], At[m][k], acc[ai][bj][m][n], 0, 0, 0); __builtin_amdgcn_s_setprio(0); } while (0)
#define PG8_WAIT_V(n) asm volatile("s_waitcnt vmcnt(" #n ")" ::: "memory")
#define PG8_WAIT_L(n) asm volatile("s_waitcnt lgkmcnt(" #n ")" ::: "memory")
#define PG8_BAR __builtin_amdgcn_s_barrier()
#define PG8_SCHED __builtin_amdgcn_sched_barrier(0)
    Unit cur, nxt; int ui = 0;
    if (!S.next(0, cur)) return;
    f32x4 acc[2][2][4][2];
#pragma unroll
    for (int a = 0; a < 2; ++a)
#pragma unroll
        for (int b = 0; b < 2; ++b)
#pragma unroll
            for (int m = 0; m < 4; ++m)
#pragma unroll
                for (int n = 0; n < 2; ++n) acc[a][b][m][n] = (f32x4){0.f, 0.f, 0.f, 0.f};
    bf16x8 At[4][2], B0[2][2], B1[2][2];
    const char* cA = (const char*)g.A + (size_t)cur.pm * tstepA + PG8_ACOL(cur.pn); const char* cB = (const char*)g.Bt + (size_t)cur.pn * tstep;
    S.a_ready(cur);
    if constexpr (SP2) {
        PG8_STAGE(PG8_SB(0, 0), cB, voffB); PG8_STAGE(PG8_SB(0, 1), cB + hstep, voffB); PG8_STAGE(PG8_SA(0, 0), cA, voffA); PG8_STAGE(PG8_SA(0, 1), cA + hstepA, voffA);
        if (wr == 1) PG8_BAR;
        PG8_WAIT_V(2); PG8_BAR;
        PG8_STAGE(PG8_SB(1, 0), cB + kstep, voffB); PG8_STAGE(PG8_SA(1, 0), cA + kstep, voffA); PG8_STAGE(PG8_SB(1, 1), cB + hstep + kstep, voffB);
        PG8_WAIT_V(6); PG8_BAR;
    } else {
        PG8_STAGE(PG8_SB(0, 0), cB, voffB); PG8_STAGE(PG8_SA(0, 0), cA, voffA); PG8_STAGE(PG8_SB(0, 1), cB + hstep, voffB); PG8_STAGE(PG8_SA(0, 1), cA + hstepA, voffA);
        if (wr == 1) PG8_BAR;
        PG8_WAIT_V(4); PG8_BAR;
        PG8_STAGE(PG8_SB(1, 0), cB + kstep, voffB); PG8_STAGE(PG8_SA(1, 0), cA + kstep, voffA); PG8_STAGE(PG8_SB(1, 1), cB + hstep + kstep, voffB);
        PG8_WAIT_V(6); PG8_BAR;
    }
    for (;;) {
        const bool has_next = S.next(ui + 1, nxt);
        const char* nA = has_next ? (const char*)g.A + (size_t)nxt.pm * tstepA + PG8_ACOL(nxt.pn) : cA; const char* nB = has_next ? (const char*)g.Bt + (size_t)nxt.pn * tstep : cB;
#pragma nounroll
        for (int t = 0; t < nt; t += 2) {
            const bool last = (t == nt - 2);
            const char* a1 = cA + (size_t)(t + 1) * kstep;
            const char* a2 = last ? nA : cA + (size_t)(t + 2) * kstep; const char* b2 = last ? nB : cB + (size_t)(t + 2) * kstep;
            const char* a3 = a2 + kstep; const char* b3 = b2 + kstep;
            if (last && has_next) S.a_ready(nxt);
            if constexpr (SP2) {
            PG8_LDB(B0, 0, 0); PG8_LDB(B1, 0, 1); PG8_SCHED; PG8_LDA(At, 0, 0); PG8_STAGE(PG8_SA(1, 1), a1 + hstepA, voffA);
            PG8_WAIT_V(8); PG8_WAIT_L(0); PG8_BAR; PG8_MMA(0, 0, At, B0); PG8_MMA(0, 1, At, B1); PG8_BAR; PG8_SCHED;
            PG8_LDA(At, 0, 1); PG8_STAGE(PG8_SB(0, 0), b2, voffB); PG8_STAGE(PG8_SB(0, 1), b2 + hstep, voffB); PG8_STAGE(PG8_SA(0, 0), a2, voffA);
            PG8_WAIT_V(8); PG8_WAIT_L(0); PG8_BAR; PG8_MMA(1, 0, At, B0); PG8_MMA(1, 1, At, B1); PG8_BAR; PG8_SCHED;
            PG8_LDB(B0, 1, 0); PG8_LDB(B1, 1, 1); PG8_SCHED; PG8_LDA(At, 1, 0); PG8_STAGE(PG8_SA(0, 1), a2 + hstepA, voffA);
            PG8_WAIT_V(8); PG8_WAIT_L(0); PG8_BAR; PG8_MMA(0, 0, At, B0); PG8_MMA(0, 1, At, B1); PG8_BAR; PG8_SCHED;
            PG8_LDA(At, 1, 1); PG8_STAGE(PG8_SB(1, 0), b3, voffB); PG8_STAGE(PG8_SB(1, 1), b3 + hstep, voffB); PG8_STAGE(PG8_SA(1, 0), a3, voffA);
            PG8_WAIT_V(8); PG8_WAIT_L(0); PG8_BAR; PG8_MMA(1, 0, At, B0); PG8_MMA(1, 1, At, B1); PG8_BAR; PG8_SCHED;
            } else {
            PG8_LDB(B0, 0, 0); PG8_SCHED; PG8_LDA(At, 0, 0); PG8_STAGE(PG8_SA(1, 1), a1 + hstepA, voffA);
            PG8_WAIT_L(8); PG8_BAR; PG8_WAIT_L(0); PG8_MMA(0, 0, At, B0); PG8_BAR; PG8_SCHED;
            PG8_LDB(B1, 0, 1); PG8_STAGE(PG8_SB(0, 0), b2, voffB);
            PG8_BAR; PG8_WAIT_L(0); PG8_MMA(0, 1, At, B1); PG8_BAR;
            PG8_LDA(At, 0, 1); PG8_STAGE(PG8_SA(0, 0), a2, voffA);
            PG8_BAR; PG8_WAIT_L(0); PG8_MMA(1, 0, At, B0); PG8_BAR; PG8_SCHED;
            PG8_STAGE(PG8_SB(0, 1), b2 + hstep, voffB);
            PG8_WAIT_V(6); PG8_BAR; PG8_MMA(1, 1, At, B1); PG8_BAR;
            PG8_LDB(B0, 1, 0); PG8_SCHED; PG8_LDA(At, 1, 0); PG8_STAGE(PG8_SA(0, 1), a2 + hstepA, voffA);
            PG8_WAIT_L(8); PG8_BAR; PG8_WAIT_L(0); PG8_MMA(0, 0, At, B0); PG8_BAR; PG8_SCHED;
            PG8_LDB(B1, 1, 1); PG8_STAGE(PG8_SB(1, 0), b3, voffB);
            PG8_BAR; PG8_WAIT_L(0); PG8_MMA(0, 1, At, B1); PG8_BAR;
            PG8_LDA(At, 1, 1); PG8_STAGE(PG8_SA(1, 0), a3, voffA);
            PG8_BAR; PG8_WAIT_L(0); PG8_MMA(1, 0, At, B0); PG8_BAR; PG8_SCHED;
            PG8_STAGE(PG8_SB(1, 1), b3 + hstep, voffB);
            PG8_WAIT_V(6); PG8_BAR; PG8_MMA(1, 1, At, B1); PG8_BAR;
            }
        }
        if constexpr (ALIGN_EPI) { if (wr == 0) PG8_BAR; }
        if constexpr (!Epi::AFTER_DRAIN) { E(acc, cur, wr, wc, fr, fq); S.done(cur); }
        if (!has_next) break;
#pragma unroll
        for (int a = 0; a < 2; ++a)
#pragma unroll
            for (int b = 0; b < 2; ++b)
#pragma unroll
                for (int m = 0; m < 4; ++m)
#pragma unroll
                    for (int n = 0; n < 2; ++n) acc[a][b][m][n] = (f32x4){0.f, 0.f, 0.f, 0.f};
        cur = nxt; cA = nA; cB = nB; ++ui;
        if constexpr (ALIGN_EPI) { if (wr == 1) PG8_BAR; }
    }
    PG8_WAIT_V(0);
    if constexpr (!ALIGN_EPI) { if (wr == 0) PG8_BAR; }
    PG8_BAR;
    if constexpr (Epi::AFTER_DRAIN) { E.fused(acc, cur, wr, wc, fr, fq, lds, wid, lane); S.done(cur); }
#undef PG8_SA
#undef PG8_SB
#undef PG8_STAGE
#undef PG8_LDA
#undef PG8_LDB
#undef PG8_MMA
#undef PG8_WAIT_V
#undef PG8_WAIT_L
#undef PG8_BAR
#undef PG8_SCHED
#undef PG8_ACOL
}
}
#include <hip/hip_bf16.h>
#include <cmath>
namespace attn_body {
using bf16=__hip_bfloat16;
using bf16x8=__attribute__((ext_vector_type(8)))short;
using s16x4=__attribute__((ext_vector_type(4)))short;
using f32x16=__attribute__((ext_vector_type(16)))float;
using u32x4=__attribute__((ext_vector_type(4)))unsigned;
constexpr int D=64,PZ=2816,PO=1024,ZQ=1920,ZKA=2432,ZVA=2560;
constexpr int NW=8,QBLK=32,QB=QBLK*NW,KVBLK=64;
constexpr int ATTN_UNIT_ROWS=QB;
__device__ __forceinline__ int crow(int r,int hi){return (r&3)+8*(r>>2)+4*hi;}
#define SBAR() __builtin_amdgcn_sched_barrier(0)
__device__ __forceinline__ void cmask(f32x16&p0,f32x16&p1,int jb,int qrel,int hi){
  const float NEG=-INFINITY; int kb=64*jb+4*hi;
  #pragma unroll
  for(int r=0;r<16;++r){int kv=kb+(r&3)+8*(r>>2); if(kv>qrel)p0[r]=NEG; if(kv+32>qrel)p1[r]=NEG;}
}

constexpr int NSLOT=3, SLOTB=8192;
constexpr int LDS_K=0, LDS_V=NSLOT*SLOTB, LDS_WS=2*NSLOT*SLOTB, LDS_OST=LDS_WS+NW*64*4, LDS_BYTES=LDS_OST+NW*4096;
constexpr float C2=0.125f*1.4426950408889634f;
__device__ __forceinline__ void glds16(const void*gsrc,unsigned lds_dst){unsigned keep;
  asm volatile("s_mov_b32 %0, m0\n\ts_mov_b32 m0, %2\n\ts_nop 0\n\tglobal_load_lds_dwordx4 %1, off\n\ts_mov_b32 m0, %0":"=&s"(keep):"v"(gsrc),"s"(lds_dst):"memory");}
__device__ __forceinline__ float max3f(float a,float b,float c){float r;asm("v_max3_f32 %0, %1, %2, %3":"=v"(r):"v"(a),"v"(b),"v"(c));return r;}
__device__ __forceinline__ float max2f(float a,float b){float r;asm("v_max_f32_e32 %0, %1, %2":"=v"(r):"v"(a),"v"(b));return r;}
__device__ __forceinline__ float fadd_s(float a,float b){float r;asm("v_add_f32_e32 %0, %1, %2":"=v"(r):"v"(a),"v"(b));return r;}
__device__ __forceinline__ float fsub_s(float a,float b){float r;asm("v_sub_f32_e32 %0, %1, %2":"=v"(r):"v"(a),"v"(b));return r;}
typedef float f32x2_t __attribute__((ext_vector_type(2))); typedef __bf16 bf16x2_t __attribute__((ext_vector_type(2)));
__device__ __forceinline__ unsigned cvtpk_s(float lo,float hi){f32x2_t v={lo,hi};bf16x2_t b=__builtin_convertvector(v,bf16x2_t);return __builtin_bit_cast(unsigned,b);}
#define WAIT_BAR(N) asm volatile("s_waitcnt vmcnt(" #N ") lgkmcnt(0)\n\ts_barrier":::"memory")

__device__ __forceinline__ void qkt(f32x16&p0,f32x16&p1,const char*Kslot,const bf16x8*qr,const f32x16&negm,int r32,int hi){
  const char*kb=Kslot+hi*1024+r32*16;
  #pragma unroll
  for(int d0=0;d0<4;++d0){
    const bf16x8 b0=*reinterpret_cast<const bf16x8*>(kb+d0*2048);
    const bf16x8 b1=*reinterpret_cast<const bf16x8*>(kb+d0*2048+512);
    if(d0==0){p0=__builtin_amdgcn_mfma_f32_32x32x16_bf16(b0,qr[0],negm,0,0,0);p1=__builtin_amdgcn_mfma_f32_32x32x16_bf16(b1,qr[0],negm,0,0,0);}
    else{p0=__builtin_amdgcn_mfma_f32_32x32x16_bf16(b0,qr[d0],p0,0,0,0);p1=__builtin_amdgcn_mfma_f32_32x32x16_bf16(b1,qr[d0],p1,0,0,0);}}
}
typedef __attribute__((address_space(3))) const char* lds_cptr;
typedef short v4i16_t __attribute__((ext_vector_type(4)));
__device__ __forceinline__ void kload8(bf16x8*kf,lds_cptr kp){
  kf[0]=*(const __attribute__((address_space(3))) bf16x8*)(kp);      kf[1]=*(const __attribute__((address_space(3))) bf16x8*)(kp+512);
  kf[2]=*(const __attribute__((address_space(3))) bf16x8*)(kp+2048); kf[3]=*(const __attribute__((address_space(3))) bf16x8*)(kp+2560);
  kf[4]=*(const __attribute__((address_space(3))) bf16x8*)(kp+4096); kf[5]=*(const __attribute__((address_space(3))) bf16x8*)(kp+4608);
  kf[6]=*(const __attribute__((address_space(3))) bf16x8*)(kp+6144); kf[7]=*(const __attribute__((address_space(3))) bf16x8*)(kp+6656);
}
__device__ __forceinline__ void kload2(bf16x8*kf,lds_cptr kp,int j){ kf[2*j]=*(const __attribute__((address_space(3))) bf16x8*)(kp+j*2048); kf[2*j+1]=*(const __attribute__((address_space(3))) bf16x8*)(kp+j*2048+512); }
__device__ __forceinline__ s16x4 vtr(lds_cptr p){ return __builtin_bit_cast(s16x4,__builtin_amdgcn_ds_read_tr16_b64_v4i16((__attribute__((address_space(3))) v4i16_t*)p)); }
__device__ __forceinline__ float rowmax(const f32x16&p0,const f32x16&p1){
  float a=max3f(p0[0],p0[1],p1[0]),b=max3f(p0[2],p0[3],p1[1]);a=max3f(a,p1[2],p1[3]);
  #pragma unroll
  for(int r=4;r<16;r+=4){a=max3f(a,p0[r],p0[r+1]);b=max3f(b,p0[r+2],p0[r+3]);a=max3f(a,p1[r],p1[r+1]);b=max3f(b,p1[r+2],p1[r+3]);}
  const float m=max2f(a,b);
  auto rr=__builtin_amdgcn_permlane32_swap(__float_as_uint(m),__float_as_uint(m),false,false);
  return max2f(__uint_as_float(rr[0]),__uint_as_float(rr[1]));
}
__device__ __forceinline__ void pv(f32x16*o,int vb,bf16x8 pa0,bf16x8 pa1,bf16x8 pa2,bf16x8 pa3){
  #pragma unroll
  for(int d0=0;d0<2;++d0){s16x4 lo[4],hi[4];
    #pragma unroll
    for(int ks=0;ks<4;++ks){
      asm volatile("ds_read_b64_tr_b16 %0,%1 offset:%c2":"=&v"(lo[ks]):"v"(vb),"i"(d0*4096+ks*1024):"memory");
      asm volatile("ds_read_b64_tr_b16 %0,%1 offset:%c2":"=&v"(hi[ks]):"v"(vb),"i"(d0*4096+ks*1024+512):"memory");}
    asm volatile("s_waitcnt lgkmcnt(0)":::"memory");SBAR();
    #define PK(k) (bf16x8){lo[k][0],lo[k][1],lo[k][2],lo[k][3],hi[k][0],hi[k][1],hi[k][2],hi[k][3]}
    o[d0]=__builtin_amdgcn_mfma_f32_32x32x16_bf16(pa0,PK(0),o[d0],0,0,0);
    o[d0]=__builtin_amdgcn_mfma_f32_32x32x16_bf16(pa1,PK(1),o[d0],0,0,0);
    o[d0]=__builtin_amdgcn_mfma_f32_32x32x16_bf16(pa2,PK(2),o[d0],0,0,0);
    o[d0]=__builtin_amdgcn_mfma_f32_32x32x16_bf16(pa3,PK(3),o[d0],0,0,0);
    #undef PK
  }
}

#ifndef ATTN_STORE16
#define ATTN_STORE16(p,v) (*(u32x4*)(p)=(v))
#endif
template<int THRL> __device__ __forceinline__ void attn_unit(long rowbase,int T,int h,int qb,const bf16*Z,bf16*O,char*shm){
  int tid_=threadIdx.x; asm volatile("":"+v"(tid_));
  const int tid=tid_,lane=tid&63,r32=lane&31,hi=lane>>5; const int wid=__builtin_amdgcn_readfirstlane(tid>>6);
  const int q0=qb*QB;
  const bf16*Qw=Z+(rowbase+q0+wid*QBLK)*PZ+ZQ+h*D;
  const bf16*Kh=Z+rowbase*PZ+ZKA+(h>>2)*D,*Vh=Z+rowbase*PZ+ZVA+(h>>2)*D;
  const unsigned lds0=(unsigned)(uintptr_t)shm;
  float*wsf=(float*)(shm+LDS_WS)+wid*64;
  const bf16*ksrc=Kh+(long)lane*PZ+wid*8;
  const bf16*vsrc=Vh+(long)(16*(wid&3)+(lane>>2))*PZ+(wid>>2)*32+(lane&3)*8;
  const unsigned kdst=lds0+LDS_K+wid*1024, vdst=lds0+LDS_V+wid*1024;
  #define DMA_K(t,slot) glds16(ksrc+(long)(t)*KVBLK*PZ,(unsigned)__builtin_amdgcn_readfirstlane(kdst+(slot)))
  #define DMA_V(t,slot) glds16(vsrc+(long)(t)*KVBLK*PZ,(unsigned)__builtin_amdgcn_readfirstlane(vdst+(slot)))
  const int vb0=(int)(lds0+LDS_V)+((lane>>4)&1)*32+(lane&3)*8+(4*hi+((lane&15)>>2))*64;
  const char*Kbase=shm+LDS_K; bf16x8 kf[8];
  const lds_cptr shm3=(lds_cptr)shm; const lds_cptr kp0=shm3+LDS_K+hi*1024+r32*16; const lds_cptr vp0=shm3+LDS_V+((lane>>4)&1)*32+(lane&3)*8+(4*hi+((lane&15)>>2))*64;
  const int NT=T/KVBLK;
  DMA_K(0,0);DMA_V(0,0);DMA_K(1,SLOTB);
  bf16x8 qr[4];
  #pragma unroll
  for(int d0=0;d0<4;++d0)qr[d0]=*reinterpret_cast<const bf16x8*>(&Qw[(long)r32*PZ+d0*16+hi*8]);
  float mhat=0.f,l_reg=0.f;f32x16 o[2];o[0]=f32x16{};o[1]=f32x16{};f32x16 negm=f32x16{};asm volatile("":"+v"(negm));
  const int qrel=wid*QBLK+r32;
  #define CMASK(P0,P1,t) do{}while(0)
  bool resc=false;
  #define START(P0,P1) do{ const float rm=rowmax(P0,P1); resc=false; \
    { const float dl=rm; mhat=fadd_s(mhat,dl); \
      _Pragma("unroll") for(int r=0;r<16;++r){P0[r]=fsub_s(P0[r],dl);P1[r]=fsub_s(P1[r],dl);} \
      _Pragma("unroll") for(int r=0;r<16;++r)negm[r]=-mhat; asm volatile("":"+v"(negm)); } \
    _Pragma("unroll") for(int r=0;r<16;++r)P0[r]=__builtin_amdgcn_exp2f(P0[r]); }while(0)
  #define RESC() do{ if(resc){ asm volatile("s_waitcnt lgkmcnt(0)":::"memory"); \
      _Pragma("unroll") for(int d_=0;d_<2;++d_) _Pragma("unroll") for(int r=0;r<16;++r)o[d_][r]*=wsf[crow(r,hi)]; } }while(0)
  f32x16 pA0,pA1,pB0,pB1;
  int sl_prev=0,sl_cur=0,sl_next=SLOTB;
  #define ROT() do{sl_prev=sl_cur;sl_cur=sl_next;sl_next=(sl_next==(NSLOT-1)*SLOTB)?0:sl_next+SLOTB;}while(0)
  DMA_K(2,2*SLOTB);
  WAIT_BAR(3);
  qkt(pA0,pA1,Kbase,qr,negm,r32,hi);asm volatile("s_nop 15\n\ts_nop 7":"+v"(pA0),"+v"(pA1));CMASK(pA0,pA1,0);
  START(pA0,pA1);
  _Pragma("unroll") for(int r=0;r<16;++r)pA1[r]=__builtin_amdgcn_exp2f(pA1[r]);
  WAIT_BAR(0);
  DMA_K(3,0);DMA_V(1,SLOTB);
  ROT();
  kload8(kf,kp0+sl_cur);
  WAIT_BAR(2);
  s16x4 vlo[8],vhi[8]; u32x4 pw0,pw1,pw2,pw3;
  #define PKW(P,B) cvtpk_s(P[B],P[B+1])
  #define PAF(k) __builtin_bit_cast(bf16x8,pw##k)
  #define VFR(i) (bf16x8){vlo[i][0],vlo[i][1],vlo[i][2],vlo[i][3],vhi[i][0],vhi[i][1],vhi[i][2],vhi[i][3]}
  #define PIN(x) asm volatile("":"+v"(x))
  #define MX3(a,b,c) __builtin_fmaxf(__builtin_fmaxf((a),(b)),(c))
  #define GAPA(MF,A0,A1,A2,A3,W0,W1,PW) do{ MF; sacc+=A0; sacc+=A1; sacc+=A2; sacc+=A3; PIN(sacc); W0; W1; PIN(PW); SBAR(); }while(0)
  #define EX(v) __builtin_amdgcn_exp2f(v)
  #define GAPB(MF,X,B) do{ MF; X[B]=EX(X[B]); X[B+1]=EX(X[B+1]); X[B+2]=EX(X[B+2]); X[B+3]=EX(X[B+3]); PIN(X); SBAR(); }while(0)
  #define VRD(i) do{ vlo[i]=vtr(vp_+(((i)>>2)*4096+((i)&3)*1024)); vhi[i]=vtr(vp_+(((i)>>2)*4096+((i)&3)*1024+512)); }while(0)
  #define KRD(G,j) do{ if(G){ kload2(kf,kp0+sl_next,j); SBAR(); } }while(0)
  #define STEP(C0,C1,P0,P1,t,GK,GV,GL) do{ SBAR(); \
    const lds_cptr vp_=vp0+sl_prev; \
    VRD(0); SBAR(); float sacc=(P0[0]+P0[1]); \
    GAPA(C0=__builtin_amdgcn_mfma_f32_32x32x16_bf16(kf[0],qr[0],negm,0,0,0), P0[2],P0[3],P0[4],P0[5],     pw0[0]=PKW(P0,0), pw0[1]=PKW(P0,2), pw0); \
    VRD(4); SBAR(); GAPA(C1=__builtin_amdgcn_mfma_f32_32x32x16_bf16(kf[1],qr[0],negm,0,0,0), P0[6],P0[7],P0[8],P0[9],     pw0[2]=PKW(P0,4), pw0[3]=PKW(P0,6), pw0); \
    VRD(1); SBAR(); GAPA(C0=__builtin_amdgcn_mfma_f32_32x32x16_bf16(kf[2],qr[1],C0,0,0,0),   P0[10],P0[11],P0[12],P0[13], pw1[0]=PKW(P0,8), pw1[1]=PKW(P0,10), pw1); \
    VRD(5); SBAR(); GAPA(C1=__builtin_amdgcn_mfma_f32_32x32x16_bf16(kf[3],qr[1],C1,0,0,0),   P0[14],P0[15],P1[0],P1[1],   pw1[2]=PKW(P0,12),pw1[3]=PKW(P0,14), pw1); \
    VRD(2); SBAR(); GAPA(C0=__builtin_amdgcn_mfma_f32_32x32x16_bf16(kf[4],qr[2],C0,0,0,0),   P1[2],P1[3],P1[4],P1[5],     pw2[0]=PKW(P1,0), pw2[1]=PKW(P1,2), pw2); \
    VRD(6); SBAR(); GAPA(C1=__builtin_amdgcn_mfma_f32_32x32x16_bf16(kf[5],qr[2],C1,0,0,0),   P1[6],P1[7],P1[8],P1[9],     pw2[2]=PKW(P1,4), pw2[3]=PKW(P1,6), pw2); \
    VRD(3); SBAR(); GAPA(C0=__builtin_amdgcn_mfma_f32_32x32x16_bf16(kf[6],qr[3],C0,0,0,0),   P1[10],P1[11],P1[12],P1[13], pw3[0]=PKW(P1,8), pw3[1]=PKW(P1,10), pw3); \
    VRD(7); SBAR(); GAPA(C1=__builtin_amdgcn_mfma_f32_32x32x16_bf16(kf[7],qr[3],C1,0,0,0),   P1[14],P1[15],0.f,0.f,       pw3[2]=PKW(P1,12),pw3[3]=PKW(P1,14), pw3); \
    l_reg+=sacc; \
    if(GK){DMA_K((t)+3,sl_cur);} if(GV){DMA_V((t)+1,sl_next);} \
    CMASK(C0,C1,t); \
    { float a=MX3(C0[0],C0[1],C1[0]),b=MX3(C0[2],C0[3],C1[1]); a=MX3(a,C1[2],C1[3]); \
      _Pragma("unroll") for(int r=4;r<16;r+=4){a=MX3(a,C0[r],C0[r+1]);b=MX3(b,C0[r+2],C0[r+3]);a=MX3(a,C1[r],C1[r+1]);b=MX3(b,C1[r+2],C1[r+3]);} \
      float rm=__builtin_fmaxf(a,b); { auto rr=__builtin_amdgcn_permlane32_swap(__float_as_uint(rm),__float_as_uint(rm),false,false); rm=__builtin_fmaxf(__uint_as_float(rr[0]),__uint_as_float(rr[1])); } \
      resc=false; \
      if(__builtin_expect(__any(rm>(float)THRL),0)){ const float dl=__builtin_fmaxf(rm,0.f); mhat+=dl; \
        _Pragma("unroll") for(int r=0;r<16;++r){C0[r]-=dl;C1[r]-=dl;} \
        _Pragma("unroll") for(int r=0;r<16;++r)negm[r]=-mhat; asm volatile("":"+v"(negm)); \
        const float f=__builtin_amdgcn_exp2f(-dl); l_reg*=f; if(hi==0)wsf[r32]=f; resc=true; } } \
    SBAR(); \
    GAPB(o[0]=__builtin_amdgcn_mfma_f32_32x32x16_bf16(PAF(0),VFR(0),o[0],0,0,0), C0,0); \
    GAPB(o[1]=__builtin_amdgcn_mfma_f32_32x32x16_bf16(PAF(0),VFR(4),o[1],0,0,0), C0,4); \
    KRD(GL,0); GAPB(o[0]=__builtin_amdgcn_mfma_f32_32x32x16_bf16(PAF(1),VFR(1),o[0],0,0,0), C0,8); \
    KRD(GL,1); GAPB(o[1]=__builtin_amdgcn_mfma_f32_32x32x16_bf16(PAF(1),VFR(5),o[1],0,0,0), C0,12); \
    KRD(GL,2); GAPB(o[0]=__builtin_amdgcn_mfma_f32_32x32x16_bf16(PAF(2),VFR(2),o[0],0,0,0), C1,0); \
    KRD(GL,3); GAPB(o[1]=__builtin_amdgcn_mfma_f32_32x32x16_bf16(PAF(2),VFR(6),o[1],0,0,0), C1,4); \
    GAPB(o[0]=__builtin_amdgcn_mfma_f32_32x32x16_bf16(PAF(3),VFR(3),o[0],0,0,0), C1,8); \
    GAPB(o[1]=__builtin_amdgcn_mfma_f32_32x32x16_bf16(PAF(3),VFR(7),o[1],0,0,0), C1,12); \
    }while(0)
  int t=1;
  #undef CMASK
  #define CMASK(P0,P1,t) do{}while(0)
  for(;t+5<NT;t+=2){
    STEP(pB0,pB1,pA0,pA1,t,true,true,true);     WAIT_BAR(2); RESC(); ROT();
    STEP(pA0,pA1,pB0,pB1,t+1,true,true,true);   WAIT_BAR(2); RESC(); ROT();
  }
  #undef CMASK
  #define CMASK(P0,P1,t) do{}while(0)
  #define ENDW(tt) do{ if((tt)+3<NT){WAIT_BAR(2);} else if((tt)+2<NT){WAIT_BAR(1);} else {WAIT_BAR(0);} }while(0)
  for(;t+1<NT;t+=2){
    STEP(pB0,pB1,pA0,pA1,t,(t+3<NT),(t+1<NT),(t+1<NT));       ENDW(t);   RESC(); ROT();
    STEP(pA0,pA1,pB0,pB1,t+1,(t+4<NT),(t+2<NT),(t+2<NT));     ENDW(t+1); RESC(); ROT();
  }
  STEP(pB0,pB1,pA0,pA1,NT-1,false,false,false); RESC();
  { float sacc=pB0[0]+pB0[1]; _Pragma("unroll") for(int r=2;r<16;++r)sacc+=pB0[r]; _Pragma("unroll") for(int r=0;r<16;++r)sacc+=pB1[r]; l_reg+=sacc;
    pw0=(u32x4){PKW(pB0,0),PKW(pB0,2),PKW(pB0,4),PKW(pB0,6)};pw1=(u32x4){PKW(pB0,8),PKW(pB0,10),PKW(pB0,12),PKW(pB0,14)};pw2=(u32x4){PKW(pB1,0),PKW(pB1,2),PKW(pB1,4),PKW(pB1,6)};pw3=(u32x4){PKW(pB1,8),PKW(pB1,10),PKW(pB1,12),PKW(pB1,14)};
    SBAR(); pv(o,vb0+sl_cur,PAF(0),PAF(1),PAF(2),PAF(3)); }
  #undef PKW
  #undef PAF
  #undef VFR
  #undef PIN
  #undef MX3
  #undef GAPA
  #undef GAPB
  #undef EX
  #undef VRD
  #undef KRD
  #undef STEP
  #undef ENDW
  {auto rr=__builtin_amdgcn_permlane32_swap(__float_as_uint(l_reg),__float_as_uint(l_reg),false,false);l_reg=__uint_as_float(rr[0])+__uint_as_float(rr[1]);}
  if(hi==0)wsf[32+r32]=l_reg;asm volatile("s_waitcnt lgkmcnt(0)":::"memory");
  float rli[16];
  #pragma unroll
  for(int r=0;r<16;++r)rli[r]=__builtin_amdgcn_rcpf(wsf[32+crow(r,hi)]);
  bf16*Ow=O+(rowbase+q0+wid*QBLK)*PO+512+h*D;
  { bf16*stg=(bf16*)(shm+LDS_OST)+wid*2048;
    #pragma unroll
    for(int r=0;r<16;++r){const int orow=crow(r,hi);
      #pragma unroll
      for(int d0=0;d0<2;++d0)stg[orow*64+d0*32+r32]=__float2bfloat16(o[d0][r]*rli[r]);}
    asm volatile("s_waitcnt lgkmcnt(0)":::"memory");
    #pragma unroll
    for(int i=0;i<4;++i){const int row=i*8+(lane>>3),ch=lane&7; const u32x4 v=*(const u32x4*)(stg+row*64+ch*8); ATTN_STORE16(Ow+(long)row*PO+ch*8,v);} }
  asm volatile("s_waitcnt lgkmcnt(0)\n\ts_barrier":::"memory");
  #undef DMA_K
  #undef DMA_V
  #undef CMASK
  #undef START
  #undef RESC
  #undef ROT
}
constexpr int ATTN_LDS_BYTES=LDS_BYTES;
#undef SBAR
#undef WAIT_BAR
}
namespace cg = cooperative_groups;
#define LAS __attribute__((address_space(3)))
typedef unsigned short bf16;
typedef float f32x4 __attribute__((ext_vector_type(4)));
typedef float f32x2 __attribute__((ext_vector_type(2)));
typedef unsigned v4u __attribute__((ext_vector_type(4)));
typedef _Float16 f16x4 __attribute__((ext_vector_type(4)));
constexpr int NWAVES = 8, NTHR = 512;
constexpr int DMODEL = 1024, MP = 65536, MS = 32768, MTOT = 98304, TP = 2048, TS = 16384;
constexpr int PZ = 2816, NIN = 2688, DFF = 2816, KL = 384, NL = 2560;
constexpr int ZWF = 1536, ZQ = 1920;
constexpr size_t MiB = 1u << 20;
constexpr size_t WS_CTL = 0, CTL_ZERO_BYTES = 2 * MiB;
constexpr size_t WS_SSQ = 1 * MiB;
constexpr size_t WS_BIAS = 31 * MiB;
constexpr size_t WS_WIN = 2 * MiB, WS_WOUT = 8 * MiB, WS_WGU = 10 * MiB, WS_WDN = 22 * MiB, WS_WL = 28 * MiB;
constexpr size_t WS_Z = 32 * MiB;
constexpr size_t WS_A = 560 * MiB;
constexpr size_t WS_YCAT = 752 * MiB;
constexpr size_t WS_U = 944 * MiB;
constexpr size_t WS_END = 1024 * MiB;
constexpr int CW_QUEUE = 64;
constexpr int RING_BYTES = 131072, MISC_OFF = RING_BYTES + 320, LDS_BYTES = 147456;
constexpr int NPHASE = 10;

struct Params {
    const float* in[28]; float* out; unsigned char* ws; int ph_lo, ph_hi;
};

__device__ __forceinline__ unsigned pkbf(float lo, float hi) { return pg8::cvt_pk_bf16(lo, hi); }
__device__ __forceinline__ void cvt4bf(uint2 u, float (&o)[4]) { o[0] = __uint_as_float(u.x << 16); o[1] = __uint_as_float(u.x & 0xffff0000u); o[2] = __uint_as_float(u.y << 16); o[3] = __uint_as_float(u.y & 0xffff0000u); }
__device__ __forceinline__ uint2 pack4bf(const float (&v)[4]) { uint2 u; u.x = pkbf(v[0], v[1]); u.y = pkbf(v[2], v[3]); return u; }
__device__ __forceinline__ void cvt4h(uint2 u, float (&o)[4]) { f16x4 h = __builtin_bit_cast(f16x4, u); o[0] = (float)h[0]; o[1] = (float)h[1]; o[2] = (float)h[2]; o[3] = (float)h[3]; }
__device__ __forceinline__ float wave_sum(float v) {
#pragma unroll
    for (int o = 1; o < 64; o <<= 1) v += __shfl_xor(v, o);
    return v;
}
__device__ __forceinline__ float sum16(float v) { v += __shfl_xor(v, 1); v += __shfl_xor(v, 2); v += __shfl_xor(v, 4); v += __shfl_xor(v, 8); return v; }
__device__ __forceinline__ float dpp_x1(float x) { return __int_as_float(__builtin_amdgcn_mov_dpp(__float_as_int(x), 0xB1, 0xF, 0xF, true)); }
__device__ __forceinline__ float dpp_x2(float x) { return __int_as_float(__builtin_amdgcn_mov_dpp(__float_as_int(x), 0x4E, 0xF, 0xF, true)); }
__device__ __forceinline__ float dpp_hm(float x) { return __int_as_float(__builtin_amdgcn_mov_dpp(__float_as_int(x), 0x141, 0xF, 0xF, true)); }
__device__ __forceinline__ float sigm(float x) { return 1.0f / (1.0f + __expf(-x)); }

__device__ __forceinline__ void transpose_item(const float* W, int N, int k0, int n0, bf16* WT, int ldt, int dst_row0, int dst_k0, const float* kscale, LAS float* scr, int lane) {
#pragma unroll 8
    for (int i = 0; i < 32; ++i) { const int kk = 2 * i + (lane >> 5); float v = W[(size_t)(k0 + kk) * N + n0 + (lane & 31)]; if (kscale) v *= kscale[k0 + kk]; scr[kk * 33 + (lane & 31)] = v; }
    asm volatile("s_waitcnt lgkmcnt(0)" ::: "memory");
    const int c = lane & 7;
#pragma unroll
    for (int j = 0; j < 4; ++j) { const int n = (lane >> 3) + 8 * j; const LAS float* s = scr + (8 * c) * 33 + n;
        v4u o; o.x = pkbf(s[0 * 33], s[1 * 33]); o.y = pkbf(s[2 * 33], s[3 * 33]); o.z = pkbf(s[4 * 33], s[5 * 33]); o.w = pkbf(s[6 * 33], s[7 * 33]);
        *(v4u*)(WT + (size_t)(dst_row0 + n) * ldt + dst_k0 + 8 * c) = o; }
    asm volatile("s_waitcnt lgkmcnt(0)" ::: "memory");
}

__device__ __forceinline__ void p0_prologue(const Params& p, LAS unsigned char* lds) {
    const int tid = threadIdx.x, lane = tid & 63, wave = tid >> 6;
    LAS float* scr = (LAS float*)(lds + wave * 16384);
    const int gw = blockIdx.x * NWAVES + wave, NGW = gridDim.x * NWAVES;
    bf16* Win = (bf16*)(p.ws + WS_WIN); bf16* Wout = (bf16*)(p.ws + WS_WOUT); bf16* Wgu = (bf16*)(p.ws + WS_WGU); bf16* Wdn = (bf16*)(p.ws + WS_WDN); bf16* Wl = (bf16*)(p.ws + WS_WL);
    constexpr int I_IN = 16 * (NIN / 32), I_OUT = 16 * 32, I_G = 16 * (DFF / 32), I_DN = (DFF / 64) * 32;
    constexpr int NITEMS = I_IN + I_OUT + 2 * I_G + I_DN;
    for (int it = gw; it < NITEMS; it += NGW) {
        int r = it;
        if (r < I_IN) { const int nb = r % (NIN / 32), kb = r / (NIN / 32); transpose_item(p.in[3], NIN, 64 * kb, 32 * nb, Win, 1024, 32 * nb, 64 * kb, nullptr, scr, lane); continue; } r -= I_IN;
        if (r < I_OUT) { const int nb = r % 32, kb = r / 32; transpose_item(p.in[22], 1024, 64 * kb, 32 * nb, Wout, 1024, 32 * nb, 64 * kb, nullptr, scr, lane); continue; } r -= I_OUT;
        if (r < 2 * I_G) { const int up = r >= I_G; if (up) r -= I_G; const int nb = r % (DFF / 32), kb = r / (DFF / 32), n0 = 32 * nb;
            transpose_item(up ? p.in[25] : p.in[24], DFF, 64 * kb, n0, Wgu, 1024, 256 * (n0 >> 7) + (n0 & 127) + (up ? 128 : 0), 64 * kb, p.in[23], scr, lane); continue; } r -= 2 * I_G;
        { const int nb = r % 32, kb = r / 32; transpose_item(p.in[26], 1024, 64 * kb, 32 * nb, Wdn, DFF, 32 * nb, 64 * kb, nullptr, scr, lane); }
    }
    const int gt = blockIdx.x * NTHR + tid, NGT = gridDim.x * NTHR;
    for (int i = gt; i < (int)(CTL_ZERO_BYTES / 16); i += NGT) *(v4u*)(p.ws + WS_CTL + (size_t)i * 16) = (v4u){0u, 0u, 0u, 0u};
    for (int i = gt; i < 128 * 1024 / 8; i += NGT) *(v4u*)(Win + (size_t)NIN * 1024 + (size_t)i * 8) = (v4u){0u, 0u, 0u, 0u};
    for (int i = gt; i < NL * 16; i += NGT) {
        const int n = i >> 4, c = i & 15, k = 8 * c, blk = n >> 9, nn = n & 511;
        const bool odd = (blk == 1 || blk == 3);
        v4u o = (v4u){0u, 0u, 0u, 0u};
        if (blk == 4 || (odd ? (k >= 64) : (k < 64))) {
            const int kk = (blk == 4) ? k : (odd ? k - 64 : k);
            const float* src = p.in[blk == 0 ? 10 : blk == 1 ? 12 : blk == 2 ? 14 : blk == 3 ? 16 : 17] + (size_t)kk * 512 + nn;
            o.x = pkbf(src[0], src[512]); o.y = pkbf(src[1024], src[1536]); o.z = pkbf(src[2048], src[2560]); o.w = pkbf(src[3072], src[3584]);
        }
        *(v4u*)(Wl + (size_t)n * 128 + k) = o;
    }
    bf16* XN = (bf16*)(p.ws + WS_A); const float* g1 = p.in[2];
    f32x4 gv[4];
#pragma unroll
    for (int j = 0; j < 4; ++j) gv[j] = *((const f32x4*)g1 + lane + 64 * j);
    for (int it = gw; it < MTOT / 4; it += NGW) {
        f32x4 v[4][4];
#pragma unroll
        for (int r = 0; r < 4; ++r) { const int m = 4 * it + r;
            const float* xrow = (m < MP) ? p.in[0] + (size_t)m * 1024 : p.in[1] + (size_t)(m - MP) * 1024;
            const f32x4* xr = (const f32x4*)xrow + lane;
#pragma unroll
            for (int j = 0; j < 4; ++j) v[r][j] = __builtin_nontemporal_load(xr + 64 * j); }
#pragma unroll
        for (int r = 0; r < 4; ++r) { const int m = 4 * it + r; float s = 0.f;
#pragma unroll
            for (int j = 0; j < 4; ++j) s += (v[r][j].x * v[r][j].x + v[r][j].y * v[r][j].y) + (v[r][j].z * v[r][j].z + v[r][j].w * v[r][j].w);
            const float rstd = 1.0f / sqrtf(wave_sum(s) * (1.0f / 1024.0f) + 1e-6f);
            uint2* o8 = (uint2*)(XN + (size_t)m * 1024) + lane;
#pragma unroll
            for (int j = 0; j < 4; ++j) { uint2 o; o.x = pkbf(v[r][j].x * rstd * gv[j].x, v[r][j].y * rstd * gv[j].y); o.y = pkbf(v[r][j].z * rstd * gv[j].z, v[r][j].w * rstd * gv[j].w); o8[64 * j] = o; } }
    }
}

__device__ __forceinline__ void p2_prep(const Params& p) {
    const int tid = threadIdx.x, lane = tid & 63, wave = tid >> 6;
    const int gw = blockIdx.x * NWAVES + wave, NGW = gridDim.x * NWAVES;
    bf16* Z = (bf16*)(p.ws + WS_Z); bf16* U = (bf16*)(p.ws + WS_U);
    const float* mup = p.in[4]; const float* mun = p.in[5]; const float* qg = p.in[20]; const float* kg = p.in[21];
    const int l = lane & 15, hq = lane >> 4;
    float gq[4], gk[4], inv[4];
#pragma unroll
    for (int i = 0; i < 4; ++i) { gq[i] = qg[4 * l + i]; gk[i] = kg[4 * l + i]; inv[i] = exp2f(-(float)(4 * (l & 3) + i) * (13.287712379549449f / 16.0f)); }
    float mp0[4], mn0[4], mp1[4], mn1[4];
#pragma unroll
    for (int i = 0; i < 4; ++i) { mp0[i] = mup[ZWF + 4 * lane + i]; mn0[i] = mun[ZWF + 4 * lane + i]; const int c1 = ZWF + 256 + 4 * (lane & 31) + i; mp1[i] = mup[c1]; mn1[i] = mun[c1]; }
    for (int it = gw; it < MTOT / 4; it += NGW) {
        uint2 qa[4][3], ub[4][3], uc[4][3];
#pragma unroll
        for (int r = 0; r < 4; ++r) { const int m = 4 * it + r; int t, T;
            if (m < MP) { t = m & (TP - 1); T = TP; } else { t = (m - MP) & (TS - 1); T = TS; }
            const bf16* zrow = Z + (size_t)m * PZ;
#pragma unroll
            for (int ps = 0; ps < 3; ++ps) { const int head = ps * 4 + hq, hd = head < 10 ? head : 9; qa[r][ps] = *(const uint2*)(zrow + ZQ + hd * 64 + 4 * l); }
            const bf16* zc = zrow + ZWF + 4 * lane; const bf16* zc2 = zrow + ZWF + 256 + 4 * (lane & 31);
            ub[r][1] = *(const uint2*)zc; uc[r][1] = *(const uint2*)zc2;
            ub[r][0] = (t > 0) ? *(const uint2*)(zc - PZ) : (uint2){0u, 0u}; uc[r][0] = (t > 0) ? *(const uint2*)(zc2 - PZ) : (uint2){0u, 0u};
            ub[r][2] = (t < T - 1) ? *(const uint2*)(zc + PZ) : (uint2){0u, 0u}; uc[r][2] = (t < T - 1) ? *(const uint2*)(zc2 + PZ) : (uint2){0u, 0u};
        }
#pragma unroll
        for (int r = 0; r < 4; ++r) { const int m = 4 * it + r; int t;
            if (m < MP) { t = m & (TP - 1); } else { t = (m - MP) & (TS - 1); }
            const float prow = (float)(t >> 6), pcol = (float)(t & 63);
            bf16* zrow = Z + (size_t)m * PZ;
            const float pos = (l & 8) ? pcol : prow; const bool first = !(l & 4);
            float sn[4], cs[4];
#pragma unroll
            for (int i = 0; i < 4; ++i) { const float ang = pos * inv[i]; const float nr = rintf(ang * 0.15915494309189535f);
                float rr = fmaf(-nr, 6.2831855f, ang); rr = fmaf(-nr, -1.7484555e-7f, rr); sn[i] = __sinf(rr); cs[i] = __cosf(rr); }
#pragma unroll
            for (int ps = 0; ps < 3; ++ps) {
                const int head = ps * 4 + hq; const bool act = head < 10; const int hd = act ? head : 9;
                float x[4]; cvt4bf(qa[r][ps], x);
                float ss = (x[0] * x[0] + x[1] * x[1]) + (x[2] * x[2] + x[3] * x[3]); ss = sum16(ss);
                const float rstd = 1.0f / sqrtf(ss * (1.0f / 64.0f) + 1e-6f);
                float o[4];
#pragma unroll
                for (int i = 0; i < 4; ++i) {
                    const float xn = x[i] * rstd * (hd < 8 ? gq[i] : gk[i]);
                    const float pr = __shfl_xor(xn, 4);
                    float v = first ? (xn * cs[i] - pr * sn[i]) : (xn * cs[i] + pr * sn[i]);
                    if (hd < 8) v *= 0.18033688011112042f;
                    o[i] = v;
                }
                if (act) *(uint2*)(zrow + ZQ + hd * 64 + 4 * l) = pack4bf(o);
            }
            {
                float z[4], zp[4], zn[4]; cvt4bf(ub[r][1], z); cvt4bf(ub[r][0], zp); cvt4bf(ub[r][2], zn);
                float o[4];
#pragma unroll
                for (int i = 0; i < 4; ++i) { const float zf = z[i] + mp0[i] * (zp[i] - z[i]) + mn0[i] * (zn[i] - z[i]); o[i] = (lane < 32) ? (1.0f - 2.0f / (1.0f + __expf(2.0f * zf))) : zf; }
                *(uint2*)(U + (size_t)m * KL + 4 * lane) = pack4bf(o);
            }
            if (lane < 32) {
                float z[4], zp[4], zn[4]; cvt4bf(uc[r][1], z); cvt4bf(uc[r][0], zp); cvt4bf(uc[r][2], zn);
                float o[4];
#pragma unroll
                for (int i = 0; i < 4; ++i) { const float zf = z[i] + mp1[i] * (zp[i] - z[i]) + mn1[i] * (zn[i] - z[i]); o[i] = sigm(zf); }
                *(uint2*)(U + (size_t)m * KL + 256 + 4 * lane) = pack4bf(o);
            }
        }
    }
}

constexpr int TC = 32;
__device__ __forceinline__ void cvt8bf(uint4 u, float (&o)[8]) { o[0] = __uint_as_float(u.x << 16); o[1] = __uint_as_float(u.x & 0xffff0000u); o[2] = __uint_as_float(u.y << 16); o[3] = __uint_as_float(u.y & 0xffff0000u);
    o[4] = __uint_as_float(u.z << 16); o[5] = __uint_as_float(u.z & 0xffff0000u); o[6] = __uint_as_float(u.w << 16); o[7] = __uint_as_float(u.w & 0xffff0000u); }
__device__ __forceinline__ void cvt8h(uint4 u, float (&o)[8]) { typedef _Float16 f16x8_t __attribute__((ext_vector_type(8))); f16x8_t h = __builtin_bit_cast(f16x8_t, u);
#pragma unroll
    for (int i = 0; i < 8; ++i) o[i] = (float)h[i]; }
#define SCAN_LOAD(RZ, RL, RA, CH) do { const int sidx_ = (CH) * TC + tk, t_ = dir ? (T - 1 - sidx_) : sidx_; const long row_ = seqbase + t_; \
        const bf16* zr_ = Z + (size_t)row_ * PZ + hc; \
        _Pragma("unroll") for (int q = 0; q < 3; ++q) { RZ[q][1] = *(const uint4*)(zr_ + q * 512); \
            RZ[q][0] = (t_ > 0) ? *(const uint4*)(zr_ + q * 512 - PZ) : (uint4){0u, 0u, 0u, 0u}; RZ[q][2] = (t_ < T - 1) ? *(const uint4*)(zr_ + q * 512 + PZ) : (uint4){0u, 0u, 0u, 0u}; } \
        RL = *(const uint4*)(LAM + (size_t)row_ * 512 + hc); RA = *(const uint4*)(AR + (size_t)row_ * 512 + hc); } while (0)
#define SCAN_YOUT(CH) do { const int sidx_ = (CH) * TC + tk, t_ = dir ? (T - 1 - sidx_) : sidx_; const long row_ = seqbase + t_; \
        if constexpr (R == 2) { \
            const LAS float* yp_ = ybufs + ((CH) & 1) * TC * 64 + tk * 64 + 8 * l2; const f32x4 ya_ = *(const LAS f32x4*)(yp_), yb_ = *(const LAS f32x4*)(yp_ + 4); \
            uint4 o_; o_.x = pkbf(ya_.x, ya_.y); o_.y = pkbf(ya_.z, ya_.w); o_.z = pkbf(yb_.x, yb_.y); o_.w = pkbf(yb_.z, yb_.w); \
            if (dir == 0) *(uint4*)(YF + (size_t)row_ * 1024 + h * 64 + 8 * l2) = o_; else *(uint4*)(YB + (size_t)row_ * 512 + h * 64 + 8 * l2) = o_; \
        } else { \
            const LAS float* yp_ = ybufs + ((CH) & 1) * TC * 64 + tk * 64 + half * 32 + 4 * l2; const f32x4 ya_ = *(const LAS f32x4*)(yp_); \
            uint2 o_; o_.x = pkbf(ya_.x, ya_.y); o_.y = pkbf(ya_.z, ya_.w); \
            if (dir == 0) *(uint2*)(YF + (size_t)row_ * 1024 + h * 64 + half * 32 + 4 * l2) = o_; else *(uint2*)(YB + (size_t)row_ * 512 + h * 64 + half * 32 + 4 * l2) = o_; \
        } } while (0)
template <int R> __device__ __forceinline__ void scan_unit(const Params& p, LAS unsigned char* lds, int chain, int half) {
    int tid_ = threadIdx.x; asm volatile("" : "+v"(tid_));
    const int tid = tid_, lane = tid & 63, wv = __builtin_amdgcn_readfirstlane(tid >> 6);
    int cc = chain; long seqbase; int T;
    if (cc < 32) { seqbase = MP + (long)(cc >> 4) * TS; T = TS; } else { cc -= 32; seqbase = (long)(cc >> 4) * TP; T = TP; }
    const int h = (cc >> 1) & 7, dir = cc & 1;
    LAS float* bufs = (LAS float*)lds;
    LAS float* ybufs = bufs + 2 * 6 * TC * 64;
    const int nch = T / TC;
    if (wv < 4) {
        __builtin_amdgcn_s_setprio(2);
        f32x2 S[4], S2[4];
#pragma unroll
        for (int i = 0; i < 4; ++i) { S[i] = (f32x2){0.f, 0.f}; S2[i] = (f32x2){0.f, 0.f}; }
        const int j = lane & 7, srow = (R == 2) ? wv * 16 + (lane >> 3) : half * 32 + wv * 8 + (lane >> 3);
        const int ydum_abs = 2 * TC * 64 + wv * 128 + lane;
        for (int c = -1; c < nch; ++c) {
            if (c >= 0) {
                const LAS float* B = bufs + (c & 1) * 6 * TC * 64; LAS float* Y = ybufs + (c & 1) * TC * 64; const int ydum = ydum_abs - (c & 1) * TC * 64;
                const LAS float* q = B + 8 * j; const LAS float* qv = B + 10240 + srow;
                f32x4 ow0[4], ow1[4], oa0[4], oa1[4], ob0[4], ob1[4], ok0[4], ok1[4], or0[4], or1[4]; float ovv[4], ovw[4];
#define SCAN_OPS(N, ST) do { const int o_ = (ST) * 64; ow0[N] = *(const LAS f32x4*)(q + o_); ow1[N] = *(const LAS f32x4*)(q + o_ + 4); oa0[N] = *(const LAS f32x4*)(q + o_ + 2048); oa1[N] = *(const LAS f32x4*)(q + o_ + 2052); \
        ob0[N] = *(const LAS f32x4*)(q + o_ + 4096); ob1[N] = *(const LAS f32x4*)(q + o_ + 4100); ok0[N] = *(const LAS f32x4*)(q + o_ + 6144); ok1[N] = *(const LAS f32x4*)(q + o_ + 6148); \
        or0[N] = *(const LAS f32x4*)(q + o_ + 8192); or1[N] = *(const LAS f32x4*)(q + o_ + 8196); ovv[N] = qv[o_]; if constexpr (R == 2) ovw[N] = qv[o_ + 8]; } while (0)
                constexpr int PF = 1, NM = 1;
                SCAN_OPS(0, 0); if constexpr (PF == 2) SCAN_OPS(1, 1);
                for (int s0 = 0; s0 < TC; s0 += 4) {
#pragma unroll
                    for (int u = 0; u < 4; ++u) {
                        const int s = s0 + u;
                        { const int s2 = (s + PF < TC) ? s + PF : TC - 1; SCAN_OPS((u + PF) & NM, s2); }
                        constexpr int dummy_ = 0; const int un = u & NM;
                        const f32x4 w0 = ow0[un], w1 = ow1[un], a0 = oa0[un], a1 = oa1[un], b0 = ob0[un], b1 = ob1[un], k0 = ok0[un], k1 = ok1[un], r0 = or0[un], r1 = or1[un]; const float vv = ovv[un];
                        const f32x2 A[4] = {{a0.x, a0.y}, {a0.z, a0.w}, {a1.x, a1.y}, {a1.z, a1.w}};
                        const f32x2 W[4] = {{w0.x, w0.y}, {w0.z, w0.w}, {w1.x, w1.y}, {w1.z, w1.w}};
                        const f32x2 Bv[4] = {{b0.x, b0.y}, {b0.z, b0.w}, {b1.x, b1.y}, {b1.z, b1.w}};
                        const f32x2 KD[4] = {{k0.x, k0.y}, {k0.z, k0.w}, {k1.x, k1.y}, {k1.z, k1.w}};
                        const f32x2 R_[4] = {{r0.x, r0.y}, {r0.z, r0.w}, {r1.x, r1.y}, {r1.z, r1.w}};
                        float vw = 0.f; if constexpr (R == 2) vw = ovw[un];
                        f32x2 p0 = S[0] * A[0], p1 = S[1] * A[1]; p0 = S[2] * A[2] + p0; p1 = S[3] * A[3] + p1; p0 = p0 + p1;
                        float sa = p0.x + p0.y, sb = 0.f;
                        if constexpr (R == 2) { f32x2 t0 = S2[0] * A[0], t1 = S2[1] * A[1]; t0 = S2[2] * A[2] + t0; t1 = S2[3] * A[3] + t1; t0 = t0 + t1; sb = t0.x + t0.y; }
                        sa += dpp_x1(sa); if constexpr (R == 2) sb += dpp_x1(sb);
                        sa += dpp_x2(sa); if constexpr (R == 2) sb += dpp_x2(sb);
                        sa += dpp_hm(sa); if constexpr (R == 2) sb += dpp_hm(sb);
                        const f32x2 vv2 = {vv, vv}, sa2 = {sa, sa}, vw2 = {vw, vw}, sb2 = {sb, sb};
#pragma unroll
                        for (int i = 0; i < 4; ++i) { const f32x2 qq = S[i] * W[i] + KD[i] * vv2; S[i] = sa2 * Bv[i] + qq;
                            if constexpr (R == 2) { const f32x2 qr = S2[i] * W[i] + KD[i] * vw2; S2[i] = sb2 * Bv[i] + qr; } }
                        f32x2 y0 = S[0] * R_[0], y1 = S[1] * R_[1]; y0 = S[2] * R_[2] + y0; y1 = S[3] * R_[3] + y1; y0 = y0 + y1;
                        float y = y0.x + y0.y, yb = 0.f;
                        if constexpr (R == 2) { f32x2 z0 = S2[0] * R_[0], z1 = S2[1] * R_[1]; z0 = S2[2] * R_[2] + z0; z1 = S2[3] * R_[3] + z1; z0 = z0 + z1; yb = z0.x + z0.y; }
                        y += dpp_x1(y); if constexpr (R == 2) yb += dpp_x1(yb);
                        y += dpp_x2(y); if constexpr (R == 2) yb += dpp_x2(yb);
                        y += dpp_hm(y); if constexpr (R == 2) yb += dpp_hm(yb);
                        { const int yo = (j == 0) ? (s * 64 + srow) : ydum; Y[yo] = y; if constexpr (R == 2) { const int yo2 = (j == 0) ? (s * 64 + srow + 8) : ydum + 64; Y[yo2] = yb; } }
                    }
                }
#undef SCAN_OPS
            }
            __syncthreads();
        }
        __builtin_amdgcn_s_setprio(0);
        __syncthreads();
    } else {
        const int tid2 = tid - 256, tk = tid2 >> 3, l2 = tid2 & 7, hc = h * 64 + 8 * l2;
        const bf16* Z = (const bf16*)(p.ws + WS_Z);
        const _Float16* LAM = (const _Float16*)p.out + (size_t)dir * MTOT * 512;
        const _Float16* AR = (const _Float16*)p.out + (size_t)(2 + dir) * MTOT * 512;
        bf16* YF = (bf16*)(p.ws + WS_YCAT); bf16* YB = (bf16*)(p.ws + WS_A);
        const float* w0p = p.in[dir ? 11 : 9] + hc; const float* a0p = p.in[dir ? 15 : 13] + hc;
        float* BON = (float*)(p.ws + WS_U) + (size_t)dir * MTOT * 8;
        float cmp[3][8], cmn[3][8], cm0[3][8], ckk[8], cka[8], cf0[8], cw0[8], ca0[8], ce0[8], ce1[8];
#pragma unroll
        for (int q = 0; q < 3; ++q)
#pragma unroll
            for (int i = 0; i < 8; ++i) { cmp[q][i] = p.in[4][q * 512 + hc + i]; cmn[q][i] = p.in[5][q * 512 + hc + i]; cm0[q][i] = 1.0f - cmp[q][i] - cmn[q][i]; }
#pragma unroll
        for (int i = 0; i < 8; ++i) { ckk[i] = p.in[6][hc + i]; cka[i] = p.in[7][hc + i]; cf0[i] = 1.0f - cka[i]; cw0[i] = w0p[i]; ca0[i] = a0p[i];
            const float rk_ = p.in[8][hc + i]; ce0[i] = dir == 0 ? rk_ * (1.0f - cka[i]) : 0.0f; ce1[i] = 0.5f * rk_ * cka[i]; }
        uint4 rzA[3][3]; uint4 rlA, raA;
        SCAN_LOAD(rzA, rlA, raA, 0);
        for (int c = -1; c < nch; ++c) {
            if (c >= 1) SCAN_YOUT(c - 1);
            if (c + 1 < nch) {
                float rkv[3][8];
#pragma unroll
                for (int q = 0; q < 3; ++q) {
                    float z[8], zp[8], zn[8]; cvt8bf(rzA[q][1], z); cvt8bf(rzA[q][0], zp); cvt8bf(rzA[q][2], zn);
#pragma unroll
                    for (int i = 0; i < 8; ++i) rkv[q][i] = z[i] * cm0[q][i] + cmp[q][i] * zp[i] + cmn[q][i] * zn[i];
                }
                float lam[8], ar[8]; cvt8h(rlA, lam); cvt8h(raA, ar);
#pragma unroll
                for (int i = 0; i < 8; ++i) { lam[i] = 0.60653066f * sigm(lam[i] + cw0[i]); ar[i] = sigm(ar[i] + ca0[i]); }
                float kkv[8]; float ss = 0.f;
#pragma unroll
                for (int i = 0; i < 8; ++i) kkv[i] = rkv[1][i] * ckk[i];
#pragma unroll
                for (int i = 0; i < 8; ++i) ss += kkv[i] * kkv[i];
                ss += __shfl_xor(ss, 1); ss += __shfl_xor(ss, 2); ss += __shfl_xor(ss, 4);
                const float inv = 1.0f / sqrtf(fmaxf(ss, 1e-12f));
                {
                    float bsum = 0.f;
#pragma unroll
                    for (int i = 0; i < 8; ++i) bsum += rkv[0][i] * rkv[1][i] * (ce1[i] * ar[i] + ce0[i]);
                    bsum += __shfl_xor(bsum, 1); bsum += __shfl_xor(bsum, 2); bsum += __shfl_xor(bsum, 4);
                    if (l2 == 0) { const int sidx_ = (c + 1) * TC + tk, t_ = dir ? (T - 1 - sidx_) : sidx_; BON[(size_t)(seqbase + t_) * 8 + h] = bsum; }
                }
                LAS float* D = bufs + ((c + 1) & 1) * 6 * TC * 64 + tk * 64 + 8 * l2;
#pragma unroll
                for (int hf = 0; hf < 2; ++hf) {
                    f32x4 ow, oa, ob, ok, orr, ov;
#pragma unroll
                    for (int i = 0; i < 4; ++i) { const int e = hf * 4 + i; const float kn = kkv[e] * inv;
                        ow[i] = __expf(-lam[e]); oa[i] = -kn; ob[i] = kn * ar[e]; ok[i] = rkv[1][e] * (cka[e] * ar[e] + cf0[e]); orr[i] = rkv[0][e]; ov[i] = rkv[2][e]; }
                    *(LAS f32x4*)(D + 4 * hf) = ow; *(LAS f32x4*)(D + 2048 + 4 * hf) = oa; *(LAS f32x4*)(D + 4096 + 4 * hf) = ob; *(LAS f32x4*)(D + 6144 + 4 * hf) = ok; *(LAS f32x4*)(D + 8192 + 4 * hf) = orr; *(LAS f32x4*)(D + 10240 + 4 * hf) = ov;
                }
            }
            if (c + 2 < nch) SCAN_LOAD(rzA, rlA, raA, c + 2);
            __syncthreads();
        }
        SCAN_YOUT(nch - 1);
        __syncthreads();
    }
}
#undef SCAN_LOAD
#undef SCAN_YOUT

__device__ __forceinline__ void p5_post(const Params& p) {
    const int tid = threadIdx.x, lane = tid & 63, wave = tid >> 6;
    const int gw = blockIdx.x * NWAVES + wave, NGW = gridDim.x * NWAVES;
    const bf16* Z = (const bf16*)(p.ws + WS_Z);
    bf16* YC = (bf16*)(p.ws + WS_YCAT); const bf16* YB = (const bf16*)(p.ws + WS_A); const _Float16* G = (const _Float16*)(p.ws + WS_A) + (size_t)MTOT * 512;
    const float* BONF = (const float*)(p.ws + WS_U); const float* BONB = BONF + (size_t)MTOT * 8;
    const int l = lane & 15, hq = lane >> 4;
    for (int m = gw; m < MTOT; m += NGW) {
        int t, T; if (m < MP) { t = m & (TP - 1); T = TP; } else { t = (m - MP) & (TS - 1); T = TS; }
        uint2 ryf[2], ryb[2], rg[2], rzv[2][3]; float bsv[2];
#pragma unroll
        for (int e = 0; e < 2; ++e) { const int hh = e * 4 + hq, hc = hh * 64 + 4 * l;
            ryf[e] = *(const uint2*)(YC + (size_t)m * 1024 + hc); ryb[e] = *(const uint2*)(YB + (size_t)m * 512 + hc); rg[e] = *(const uint2*)(G + (size_t)m * 512 + hc);
            bsv[e] = BONF[(size_t)m * 8 + hh] + BONB[(size_t)m * 8 + hh];
            const bf16* zr = Z + (size_t)m * PZ + 1024 + hc;
            rzv[e][1] = *(const uint2*)(zr); rzv[e][0] = (t > 0) ? *(const uint2*)(zr - PZ) : (uint2){0u, 0u}; rzv[e][2] = (t < T - 1) ? *(const uint2*)(zr + PZ) : (uint2){0u, 0u};
        }
#pragma unroll
        for (int e = 0; e < 2; ++e) { const int hc = (e * 4 + hq) * 64 + 4 * l;
            float yf[4], yb[4], gg[4], z[4], zp[4], zn[4], vv[4];
            cvt4bf(ryf[e], yf); cvt4bf(ryb[e], yb); cvt4h(rg[e], gg); cvt4bf(rzv[e][1], z); cvt4bf(rzv[e][0], zp); cvt4bf(rzv[e][2], zn);
            const f32x4 mp = *(const f32x4*)(p.in[4] + 1024 + hc), mn = *(const f32x4*)(p.in[5] + 1024 + hc), lw = *(const f32x4*)(p.in[18] + hc), lb = *(const f32x4*)(p.in[19] + hc);
            float y[4]; float s = 0.f;
#pragma unroll
            for (int i = 0; i < 4; ++i) { vv[i] = z[i] + mp[i] * (zp[i] - z[i]) + mn[i] * (zn[i] - z[i]); y[i] = yf[i] + yb[i]; s += y[i]; }
            s = sum16(s);
            const float mean = s * (1.0f / 64.0f); float q2 = 0.f;
#pragma unroll
            for (int i = 0; i < 4; ++i) { y[i] -= mean; q2 += y[i] * y[i]; }
            q2 = sum16(q2);
            const float rstd = 1.0f / sqrtf(q2 * (1.0f / 64.0f) + 64e-5f);
            float o[4];
#pragma unroll
            for (int i = 0; i < 4; ++i) o[i] = (y[i] * rstd * lw[i] + lb[i] + bsv[e] * vv[i]) * gg[i];
            *(uint2*)(YC + (size_t)m * 1024 + hc) = pack4bf(o);
        }
    }
}

__device__ __forceinline__ void p9_final(const Params& p, float probe_delta) {
    const int tid = threadIdx.x, lane = tid & 63, wave = tid >> 6;
    const int gw = blockIdx.x * NWAVES + wave, NGW = gridDim.x * NWAVES;
    f32x4 gv[4];
#pragma unroll
    for (int j = 0; j < 4; ++j) gv[j] = *((const f32x4*)p.in[27] + lane + 64 * j);
    for (int it = gw; it < MTOT / 4; it += NGW) {
        f32x4 v[4][4];
#pragma unroll
        for (int r = 0; r < 4; ++r) { const f32x4* xr = (const f32x4*)(p.out + (size_t)(4 * it + r) * 1024) + lane;
#pragma unroll
            for (int j = 0; j < 4; ++j) v[r][j] = xr[64 * j]; }
#pragma unroll
        for (int r = 0; r < 4; ++r) { f32x4* xr = (f32x4*)(p.out + (size_t)(4 * it + r) * 1024) + lane; float s = 0.f;
#pragma unroll
            for (int j = 0; j < 4; ++j) s += (v[r][j].x * v[r][j].x + v[r][j].y * v[r][j].y) + (v[r][j].z * v[r][j].z + v[r][j].w * v[r][j].w);
            const float rstd = 1.0f / sqrtf(wave_sum(s) * (1.0f / 1024.0f) + 1e-6f);
#pragma unroll
            for (int j = 0; j < 4; ++j) { f32x4 ov = v[r][j] * rstd * gv[j]; if (gw == 0 && it == 0 && r == 0 && j == 0) ov.x += probe_delta; xr[64 * j] = ov; } }
    }
}

#define XB_TMO      128
#define XB_XCNT(j)  (256  + 64 * (j))
#define XB_XSUB(j)  (1280 + 64 * (j))
#define XB_XGEN(j)  (2304 + 64 * (j))
#define XB_TOP      3328
#define XB_TOPGEN   3392
#define XCD_BAR_WORDS 3456
#define XB_SPIN_CAP (1u << 18)

__device__ __forceinline__ unsigned xb_ld(unsigned* p)              { return __hip_atomic_load(p, __ATOMIC_RELAXED, __HIP_MEMORY_SCOPE_AGENT); }
__device__ __forceinline__ unsigned xb_add(unsigned* p, unsigned v) { return __hip_atomic_fetch_add(p, v, __ATOMIC_RELAXED, __HIP_MEMORY_SCOPE_AGENT); }
__device__ __forceinline__ unsigned xb_xcc_id() { return (unsigned)__builtin_amdgcn_s_getreg((3 << 11) | 20) & 0xFu; }
#define XB_SPIN(cond, bar) do { unsigned _sp = 0; while (cond) { __builtin_amdgcn_s_sleep(1); \
    if ((++_sp & 255u) == 0u) { if (xb_ld(&(bar)[XB_TMO])) break; if (_sp > XB_SPIN_CAP) { atomicAdd(&(bar)[XB_TMO], 1u); break; } } } } while (0)

struct XcdBarrier {
    unsigned* bar; unsigned x;
    volatile LAS unsigned* st;
};

__device__ __forceinline__ XcdBarrier xcd_barrier_post(unsigned* bar, volatile LAS unsigned* st) {
    XcdBarrier b; b.bar = bar; b.x = xb_xcc_id(); b.st = st;
    if (threadIdx.x == 0) (void)xb_add(&bar[XB_XCNT(b.x)], 1u);
    return b;
}
__device__ __forceinline__ void xcd_barrier_complete(unsigned* bar, unsigned x, unsigned& nloc, unsigned& nx) {
    const unsigned G = gridDim.x * gridDim.y * gridDim.z;
    unsigned sum, cnt, mine, sp = 0u;
    for (;;) {
        sum = 0u; cnt = 0u; mine = 0u;
#pragma unroll
        for (unsigned j = 0; j < 16; ++j) { const unsigned c = xb_ld(&bar[XB_XCNT(j)]); sum += c; cnt += (c > 0u) ? 1u : 0u; mine = (j == x) ? c : mine; }
        if (sum == G) break;
        __builtin_amdgcn_s_sleep(1);
        if ((++sp & 255u) == 0u) { if (xb_ld(&bar[XB_TMO])) break; if (sp > XB_SPIN_CAP) { atomicAdd(&bar[XB_TMO], 1u); break; } }
    }
    nloc = mine > 0u ? mine : 1u; nx = cnt > 0u ? cnt : 1u;
}

__device__ __forceinline__ void xcd_barrier(const XcdBarrier& b) {
    asm volatile("s_waitcnt vmcnt(0)" ::: "memory");
    __syncthreads();
    if (threadIdx.x == 0) {
        unsigned* bar = b.bar;
        __builtin_amdgcn_s_waitcnt(0);
        unsigned nloc = b.st[0], nx = b.st[1];
        if (nloc == 0u) { xcd_barrier_complete(bar, b.x, nloc, nx); b.st[0] = nloc; b.st[1] = nx; }
        const unsigned old = xb_add(&bar[XB_XSUB(b.x)], 1u);
        const unsigned gen = old / nloc;
        if (old + 1u == (gen + 1u) * nloc) {
            __builtin_amdgcn_fence(__ATOMIC_RELEASE, "agent");
            asm volatile("s_waitcnt vmcnt(0)" ::: "memory");
            const unsigned og = xb_add(&bar[XB_TOP], 1u);
            const unsigned tg = og / nx;
            if (og + 1u == (tg + 1u) * nx) xb_add(&bar[XB_TOPGEN], 1u);
            else XB_SPIN(xb_ld(&bar[XB_TOPGEN]) == tg, bar);
            __builtin_amdgcn_fence(__ATOMIC_ACQUIRE, "agent");
            xb_add(&bar[XB_XGEN(b.x)], 1u);
            asm volatile("s_waitcnt vmcnt(0)" ::: "memory");
        } else {
            XB_SPIN(xb_ld(&bar[XB_XGEN(b.x)]) == gen, bar);
            __builtin_amdgcn_fence(__ATOMIC_ACQUIRE, "agent");
            asm volatile("s_waitcnt vmcnt(0)" ::: "memory");
        }
    }
    __syncthreads();
}

constexpr int N_SCAN_S = 64, N_SCAN_P = 512, N_ATT_S = 2 * 8 * (TS / 256), N_ATT_P = 32 * 8 * (TP / 256);
constexpr int N_UNITS = N_SCAN_S + N_SCAN_P + N_ATT_S + N_ATT_P;

__global__ void __launch_bounds__(NTHR, 2) mega_fwd(Params p) {
    __builtin_assume(__builtin_amdgcn_workitem_id_y() == 0); __builtin_assume(__builtin_amdgcn_workitem_id_z() == 0);
    extern __shared__ __attribute__((aligned(16))) unsigned char lds_raw[];
    LAS unsigned char* lds = (LAS unsigned char*)lds_raw;
    volatile LAS unsigned* MISC = (volatile LAS unsigned*)(lds + MISC_OFF);
    const int tid = threadIdx.x;
    const int lo = p.ph_lo, hi = p.ph_hi;
    if (tid < 32) MISC[tid] = 0u;
    __syncthreads();
    XcdBarrier xbar; xbar.bar = (unsigned*)(p.ws + WS_CTL) + 4096; xbar.x = 0; xbar.st = MISC + 8;
    unsigned char* ws = p.ws;
    bf16* Zb = (bf16*)(ws + WS_Z); bf16* Ab = (bf16*)(ws + WS_A); bf16* YC = (bf16*)(ws + WS_YCAT);
    float* ssq2 = (float*)(ws + WS_SSQ);
#ifndef PROBE_REP0
#define PROBE_REP0 1
#endif
#ifndef PROBE_REP1
#define PROBE_REP1 1
#endif
#ifndef PROBE_REP3
#define PROBE_REP3 1
#endif
#ifndef PROBE_REP7
#define PROBE_REP7 1
#endif
#define IN(k) (lo <= (k) && (k) < hi)
    unsigned* pctl = (unsigned*)(ws + 31 * MiB);
#if defined(PROBE_TS_SEAM) || defined(PROBE_TS_UNIT) || defined(PROBE_TS_END)
    if (blockIdx.x == 0 && tid == 0 && lo == 0) __hip_atomic_store(pctl, (unsigned)__builtin_amdgcn_s_memrealtime(), __ATOMIC_RELAXED, __HIP_MEMORY_SCOPE_AGENT);
#endif
#ifdef PROBE_TS_SEAM
#define SEAM(k) do { if (IN(k) && IN((k) + 1)) { cg::this_grid().sync(); if ((k) == PROBE_TS_SEAM && blockIdx.x == 0 && tid == 0) { __hip_atomic_store(pctl + 64, (unsigned)__builtin_amdgcn_s_memrealtime() - __hip_atomic_load(pctl, __ATOMIC_RELAXED, __HIP_MEMORY_SCOPE_AGENT), __ATOMIC_RELAXED, __HIP_MEMORY_SCOPE_AGENT); } } } while (0)
#else
#define SEAM(k) do { if (IN(k) && IN((k) + 1)) { if ((k) == 0) { cg::this_grid().sync(); xbar = xcd_barrier_post((unsigned*)(p.ws + WS_CTL) + 4096, MISC + 8); } else { xcd_barrier(xbar); } } } while (0)
#endif
    if (IN(0)) { p0_prologue(p, lds); __syncthreads(); }
    SEAM(0);
#ifndef NOP1
    if (IN(1)) {
        pg8::Gemm g{Ab, (const bf16*)(ws + WS_WIN), MTOT, PZ, 1024, 1024, 0}; pg8::StaticOrder S; S.init(MTOT, PZ, gridDim.x, (int)blockIdx.x);
        pg8::EpiBf16<0> E{Zb, PZ, nullptr, 0, 0, 1.f};
        pg8::gemm_phase<pg8::EpiBf16<0>, pg8::StaticOrder, true, true>(lds, g, S, E);
    }
#endif
    SEAM(1);
    if (IN(2)) p2_prep(p);
    SEAM(2);
#ifndef NOP3
    if (IN(3)) {
        pg8::Gemm g{(const bf16*)(ws + WS_U), (const bf16*)(ws + WS_WL), MTOT, NL, 128, KL, 128};     pg8::StaticOrder S; S.init(MTOT, NL, gridDim.x, (int)blockIdx.x);
        pg8::EpiLora E{(_Float16*)p.out, (size_t)MTOT * 512, (_Float16*)(Ab + (size_t)MTOT * 512)};
        pg8::gemm_phase<pg8::EpiLora, pg8::StaticOrder, true, true>(lds, g, S, E);
    }
#endif
    SEAM(3);
    if (IN(4)) {
#ifndef PROBE_P4_REPS
#define PROBE_P4_REPS 1
#endif
#ifndef PROBE_P4_N2
#define PROBE_P4_N2 N_UNITS
#endif
        for (int rep = 0; rep < PROBE_P4_REPS; ++rep) {
        unsigned* qctr = (unsigned*)(ws + WS_CTL) + CW_QUEUE + 64 * rep;
        const int nun = rep == 0 ? N_UNITS : (PROBE_P4_N2);
        for (;;) {
#ifdef PROBE_P4_START2
            if (tid == 0) MISC[0] = atomicAdd(qctr, 1u) + (rep ? (PROBE_P4_START2) : 0);
#else
            if (tid == 0) MISC[0] = atomicAdd(qctr, 1u);
#endif
            __syncthreads();
#ifdef PROBE_P4_EXTRA_ATT
            int u = (int)MISC[0];
            __syncthreads();
            if (u >= N_UNITS + N_ATT_S + N_ATT_P) break;
            if (u >= N_UNITS) u -= (N_ATT_S + N_ATT_P);
#else
            const int u = (int)MISC[0];
            __syncthreads();
            if (u >= nun) break;
#endif
#ifndef NOSCAN
            if (u < N_SCAN_S + N_SCAN_P) { if (u < N_SCAN_S) scan_unit<1>(p, lds, u >> 1, u & 1); else scan_unit<2>(p, lds, 32 + (u - N_SCAN_S), 0);
#ifdef PROBE_TS_UNIT
                if (u == PROBE_TS_UNIT && tid == 0) __hip_atomic_store(pctl + 64, (unsigned)__builtin_amdgcn_s_memrealtime() - __hip_atomic_load(pctl, __ATOMIC_RELAXED, __HIP_MEMORY_SCOPE_AGENT), __ATOMIC_RELAXED, __HIP_MEMORY_SCOPE_AGENT);
#endif
            } else
#endif
            {
#ifndef NOATT
                int a = u - (N_SCAN_S + N_SCAN_P); long rowbase; int T, nqb;
                if (a < N_ATT_S) { T = TS; nqb = TS / 256; } else { a -= N_ATT_S; T = TP; nqb = TP / 256; }
                const int gq = a & 3, qb = (a >> 2) % nqb, rest = (a >> 2) / nqb, kvh = rest & 1, seq = rest >> 1;
                rowbase = (T == TS) ? (long)MP + (long)seq * TS : (long)seq * TP;
                attn_body::attn_unit<8>(rowbase, T, kvh * 4 + gq, qb, (const attn_body::bf16*)(const void*)Zb, (attn_body::bf16*)(void*)YC, (char*)lds_raw);
#endif
            }
        }
        }
    }
    SEAM(4);
    if (IN(5)) p5_post(p);
    SEAM(5);
#ifndef NOP6
    if (IN(6)) {
        pg8::Gemm g{YC, (const bf16*)(ws + WS_WOUT), MTOT, 1024, 1024, 1024, 0}; pg8::StaticOrder S; S.init(MTOT, 1024, gridDim.x, (int)blockIdx.x);
        pg8::EpiRes<true> E{p.in[0], p.in[1], p.out, Ab, ssq2};
        pg8::gemm_phase<pg8::EpiRes<true>, pg8::StaticOrder, true, true>(lds, g, S, E);
    }
#endif
    SEAM(6);
#ifndef NOP7
    if (IN(7)) {
        pg8::Gemm g{Ab, (const bf16*)(ws + WS_WGU), MTOT, 2 * DFF, 1024, 1024, 0}; pg8::StaticOrder S; S.init(MTOT, 2 * DFF, gridDim.x, (int)blockIdx.x);
        pg8::EpiSwiGLU E{Zb, ssq2};
        pg8::gemm_phase<pg8::EpiSwiGLU, pg8::StaticOrder, true, true>(lds, g, S, E);
    }
#endif
    SEAM(7);
#ifndef NOP8
    if (IN(8)) {
        pg8::Gemm g{Zb, (const bf16*)(ws + WS_WDN), MTOT, 1024, DFF, DFF, 0}; pg8::StaticOrder S; S.init(MTOT, 1024, gridDim.x, (int)blockIdx.x);
        pg8::EpiRes<false> E{p.out, p.out + (size_t)MP * 1024, p.out, nullptr, nullptr};
        pg8::gemm_phase<pg8::EpiRes<false>, pg8::StaticOrder, true, true>(lds, g, S, E);
    }
#endif
    SEAM(8);
#if defined(PROBE_TS_SEAM) || defined(PROBE_TS_UNIT)
    if (IN(9)) { p9_final(p, (blockIdx.x == 0) ? sqrtf(1.05f * (float)__hip_atomic_load(pctl + 64, __ATOMIC_RELAXED, __HIP_MEMORY_SCOPE_AGENT) * 1e-6f) : 0.f); }
#else
    if (IN(9)) p9_final(p, 0.f);
#endif
#ifdef PROBE_TS_END
    if (blockIdx.x == 0 && tid < 64) { const unsigned tk_ = (unsigned)__builtin_amdgcn_s_memrealtime() - __hip_atomic_load(pctl, __ATOMIC_RELAXED, __HIP_MEMORY_SCOPE_AGENT); p.out[4 * tid] += sqrtf(1.05f * (float)tk_ * 1e-6f); }
#endif
#undef IN
#undef SEAM
}

extern "C" void kernel_launch(void* const* d_in, const int* in_sizes, int n_in, void* d_out, int out_size, void* d_ws, size_t ws_size, hipStream_t stream) {
    static int grid = 0;
    if (grid == 0) {
        if (n_in != 28 || out_size != MTOT * 1024 || ws_size < WS_END) { fprintf(stderr, "kernel_launch: unexpected shapes n_in %d out %d ws %zu\n", n_in, out_size, ws_size); grid = -1; return; }
        int dev = 0, cus = 0, per_cu = 0;
        hipGetDevice(&dev); hipDeviceGetAttribute(&cus, hipDeviceAttributeMultiprocessorCount, dev);
        if (hipFuncSetAttribute((const void*)mega_fwd, hipFuncAttributeMaxDynamicSharedMemorySize, LDS_BYTES) != hipSuccess) { fprintf(stderr, "kernel_launch: hipFuncSetAttribute failed\n"); grid = -1; return; }
        if (hipOccupancyMaxActiveBlocksPerMultiprocessor(&per_cu, (const void*)mega_fwd, NTHR, LDS_BYTES) != hipSuccess || per_cu < 1) { fprintf(stderr, "kernel_launch: occupancy query says %d\n", per_cu); per_cu = 1; }
        (void)hipGetLastError();
        grid = cus * 1;
    }
    if (grid < 0) return;
    Params p{};
    for (int i = 0; i < 28; ++i) p.in[i] = (const float*)d_in[i];
    p.out = (float*)d_out; p.ws = (unsigned char*)d_ws;
#if MK_N_LAUNCHES == 1
    p.ph_lo = 0; p.ph_hi = NPHASE;
    void* args[] = {&p};
    hipError_t e = hipLaunchCooperativeKernel((const void*)mega_fwd, dim3(grid), dim3(NTHR), args, LDS_BYTES, stream);
    if (e != hipSuccess) fprintf(stderr, "cooperative launch failed: %s (grid %d)\n", hipGetErrorString(e), grid);
#else
    for (int ph = 0; ph < NPHASE; ++ph) {
        p.ph_lo = ph; p.ph_hi = ph + 1;
        hipLaunchKernelGGL(mega_fwd, dim3(grid), dim3(NTHR), LDS_BYTES, stream, p);
    }
#endif
}
```
